# Optimizing an MI355X kernel written in HIP

```python
import math
import jax
import jax.numpy as jnp
from jax import lax
import numpy as np

D_MODEL = 1024
BATCH = 2
SEQ = 8192
DEPTH = 1

GRID_W = 64
CTX_LEN = 256

DA_HEADS = 4
DA_HEAD_DIM = 64
DA_V_DIM = 2 * DA_HEAD_DIM
DA_WIDTH = DA_HEADS * DA_V_DIM
HG_HEADS = 4
HG_HEAD_DIM = 128
HG_WIDTH = HG_HEADS * HG_HEAD_DIM
MIX_WIDTH = DA_WIDTH + HG_WIDTH
IN_WIDTH = 3 * DA_WIDTH + 5 * HG_WIDTH
SPLITS = (DA_WIDTH, 2 * DA_WIDTH, 3 * DA_WIDTH, 3 * DA_WIDTH + HG_WIDTH,
          3 * DA_WIDTH + 2 * HG_WIDTH, 3 * DA_WIDTH + 3 * HG_WIDTH, 3 * DA_WIDTH + 4 * HG_WIDTH)
CTX_KV_END = 3 * DA_WIDTH + 3 * HG_WIDTH
CTX_SPLITS = (DA_WIDTH, 2 * DA_WIDTH, 2 * DA_WIDTH + HG_WIDTH, 2 * DA_WIDTH + 2 * HG_WIDTH)
CHUNK = 64
Q_BLOCK = 128
N_EXPERTS = 16
CAPACITY_FACTOR = 2
EXPERT_FF = 1024
ROPE_THETA = 10000.0
NORM_EPS = 1e-6

kernel_name = "hybrid_diffattn_hgrn2_ecmoe_dit_layer"


def rmsnorm(x, g):
    xf = x.astype(jnp.float32)
    y = xf * lax.rsqrt(jnp.mean(xf * xf, axis=-1, keepdims=True) + NORM_EPS)
    return (y * g.astype(jnp.float32)).astype(x.dtype)


def modulate(h, shift, scale):
    return h * (1.0 + scale) + shift


def axial_rope_tables(rows):
    half = DA_HEAD_DIM // 2
    inv_freq = 1.0 / (ROPE_THETA ** (jnp.arange(0, half, 2, dtype=jnp.float32) / half))
    r, col = jnp.meshgrid(jnp.arange(rows, dtype=jnp.float32),
                          jnp.arange(GRID_W, dtype=jnp.float32), indexing="ij")
    ang_r = r.reshape(-1)[:, None] * inv_freq
    ang_c = col.reshape(-1)[:, None] * inv_freq
    ang = jnp.concatenate([ang_r, ang_r, ang_c, ang_c], axis=-1)
    return jnp.cos(ang), jnp.sin(ang)


def apply_axial_rope(x, cos, sin):
    xf = x.astype(jnp.float32)
    x1, x2, x3, x4 = jnp.split(xf, 4, axis=-1)
    rot = jnp.concatenate([-x2, x1, -x4, x3], axis=-1)
    return (xf * cos + rot * sin).astype(x.dtype)


def qk_heads(a):
    b, t = a.shape[:2]
    return a.reshape(b, t, DA_HEADS, 2, DA_HEAD_DIM).transpose(0, 2, 3, 1, 4)


def to_heads(a, n_heads, dim):
    b, t = a.shape[:2]
    return a.reshape(b, t, n_heads, dim).transpose(0, 2, 1, 3)


def merge_heads(o):
    b, h, t, d = o.shape
    return o.transpose(0, 2, 1, 3).reshape(b, t, h * d)


def diff_attend(q, k, v, lam):
    s = jnp.einsum("bhiqd,bhikd->bhiqk", q, k).astype(jnp.float32) * (DA_HEAD_DIM ** -0.5)
    p = jax.nn.softmax(s, axis=-1)
    a = p[:, :, 0] - lam * p[:, :, 1]
    return jnp.einsum("bhqk,bhkd->bhqd", a.astype(v.dtype), v)


def hgrn2_chunk_scan(k, v, log_f, s0, q=None):
    b_, h_, t_, _ = k.shape
    dv = v.shape[-1]
    n = t_ // CHUNK

    def chunks(a):
        return jnp.moveaxis(a.astype(jnp.float32).reshape(b_, h_, n, CHUNK, a.shape[-1]), 2, 0)

    lower = jnp.tril(jnp.ones((CHUNK, CHUNK), dtype=bool))[:, :, None]

    def step(S, inp):
        kc, vc, lc = inp[0], inp[1], inp[2]
        bcum = jnp.cumsum(lc, axis=2)
        b_end = bcum[:, :, -1:, :]
        S_next = (jnp.exp(b_end[:, :, 0, :, None]) * S
                  + jnp.einsum("bhsk,bhsv->bhkv", kc * jnp.exp(b_end - bcum), vc))
        if q is None:
            return S_next, None
        qc = inp[3]
        rel = bcum[:, :, :, None, :] - bcum[:, :, None, :, :]
        decay = jnp.exp(jnp.where(lower, rel, -jnp.inf))
        scores = jnp.einsum("bhrk,bhsk,bhrsk->bhrs", qc, kc, decay)
        o = (jnp.einsum("bhrk,bhkv->bhrv", qc * jnp.exp(bcum), S)
             + jnp.einsum("bhrs,bhsv->bhrv", scores, vc))
        return S_next, o

    xs = (chunks(k), chunks(v), chunks(log_f))
    if q is not None:
        xs = xs + (chunks(q),)
    S_fin, o = lax.scan(step, s0, xs)
    if q is not None:
        o = jnp.moveaxis(o, 0, 2).reshape(b_, h_, t_, dv).astype(v.dtype)
    return o, S_fin


def forget_gate(z, lb):
    f = lb + (1.0 - lb) * jax.nn.sigmoid(z.astype(jnp.float32))
    return jnp.log(f), 1.0 - f


def token_mixer(h_lat, h_ctx, w_in, w_out, lam, lambda_init, da_subln, lb, hg_norm, cos, sin, ctx_out):
    b_ = h_lat.shape[0]
    da_q, da_k, da_v, hg_ff, hg_fb, hg_i, hg_q, hg_g = jnp.split(h_lat @ w_in, SPLITS, axis=-1)
    c_da_k, c_da_v, c_ff, c_fb, c_i = jnp.split(h_ctx @ w_in[:, DA_WIDTH:CTX_KV_END], CTX_SPLITS, axis=-1)
    if ctx_out:
        c_da_q = h_ctx @ w_in[:, :DA_WIDTH]
        c_hg_q, c_hg_g = jnp.split(h_ctx @ w_in[:, CTX_KV_END:], 2, axis=-1)

    q = apply_axial_rope(qk_heads(da_q), cos, sin)
    k_ctx = qk_heads(c_da_k)
    k_all = jnp.concatenate([k_ctx, apply_axial_rope(qk_heads(da_k), cos, sin)], axis=3)
    v_ctx = to_heads(c_da_v, DA_HEADS, DA_V_DIM)
    v_all = jnp.concatenate([v_ctx, to_heads(da_v, DA_HEADS, DA_V_DIM)], axis=2)
    t_ = q.shape[3]
    n_blk = t_ // Q_BLOCK
    q_blocks = jnp.moveaxis(q.reshape(b_, DA_HEADS, 2, n_blk, Q_BLOCK, DA_HEAD_DIM), 3, 0)
    o_blocks = lax.map(lambda qb: diff_attend(qb, k_all, v_all, lam), q_blocks)
    o_da = jnp.moveaxis(o_blocks, 0, 2).reshape(b_, DA_HEADS, t_, DA_V_DIM)
    out_da = merge_heads(rmsnorm(o_da, da_subln) * (1.0 - lambda_init))

    v_lat = to_heads(hg_i, HG_HEADS, HG_HEAD_DIM)
    v_c = to_heads(c_i, HG_HEADS, HG_HEAD_DIM)
    q_lat = to_heads(hg_q, HG_HEADS, HG_HEAD_DIM)
    q_c = to_heads(c_hg_q, HG_HEADS, HG_HEAD_DIM) if ctx_out else None
    s0 = jnp.zeros((b_, HG_HEADS, HG_HEAD_DIM, HG_HEAD_DIM), jnp.float32)
    o_hg_lat = None
    o_hg_ctx = None
    for d, (z_lat, z_ctx) in enumerate(((hg_ff, c_ff), (hg_fb, c_fb))):
        flip = (lambda a: a) if d == 0 else (lambda a: jnp.flip(a, axis=2))
        lf_l, k_l = forget_gate(z_lat, lb[d])
        lf_c, k_c = forget_gate(z_ctx, lb[d])
        k_l, lf_l = to_heads(k_l, HG_HEADS, HG_HEAD_DIM), to_heads(lf_l, HG_HEADS, HG_HEAD_DIM)
        k_c, lf_c = to_heads(k_c, HG_HEADS, HG_HEAD_DIM), to_heads(lf_c, HG_HEADS, HG_HEAD_DIM)
        o_c, S_c = hgrn2_chunk_scan(flip(k_c), flip(v_c), flip(lf_c), s0,
                                    q=None if q_c is None else flip(q_c))
        o_l, _ = hgrn2_chunk_scan(flip(k_l), flip(v_lat), flip(lf_l), S_c, q=flip(q_lat))
        o_hg_lat = flip(o_l) if o_hg_lat is None else o_hg_lat + flip(o_l)
        if ctx_out:
            o_hg_ctx = flip(o_c) if o_hg_ctx is None else o_hg_ctx + flip(o_c)
    out_hg = merge_heads(rmsnorm(o_hg_lat, hg_norm)) * jax.nn.silu(hg_g)

    y_lat = jnp.concatenate([out_da, out_hg], axis=-1) @ w_out
    if not ctx_out:
        return y_lat, None
    o_c_da = diff_attend(qk_heads(c_da_q), k_ctx, v_ctx, lam)
    out_c_da = merge_heads(rmsnorm(o_c_da, da_subln) * (1.0 - lambda_init))
    out_c_hg = merge_heads(rmsnorm(o_hg_ctx, hg_norm)) * jax.nn.silu(c_hg_g)
    y_ctx = jnp.concatenate([out_c_da, out_c_hg], axis=-1) @ w_out
    return y_lat, y_ctx


def expert_choice_ffn(h, w_router, w_gate, w_up, w_down):
    b_, t_, d_ = h.shape
    cap = CAPACITY_FACTOR * t_ // N_EXPERTS
    aff = jax.nn.softmax(jnp.einsum("btd,de->bte", h, w_router).astype(jnp.float32), axis=-1)
    top_aff, top_idx = lax.top_k(jnp.swapaxes(aff, 1, 2), cap)
    xin = jax.vmap(lambda hb, ib: hb[ib])(h, top_idx)
    g = jnp.einsum("becd,edf->becf", xin, w_gate)
    u = jnp.einsum("becd,edf->becf", xin, w_up)
    y = jnp.einsum("becf,efd->becd", jax.nn.silu(g) * u, w_down) * top_aff[..., None].astype(h.dtype)
    return jax.vmap(lambda yb, ib: jnp.zeros((t_, d_), h.dtype).at[ib.reshape(-1)].add(yb.reshape(-1, d_)))(y, top_idx)


def setup_inputs(seed: int = 0) -> dict:
    key = jax.random.key(seed)
    ks = jax.random.split(key, 24)
    D = D_MODEL

    def nrm(k, shape, scale):
        return jax.random.normal(k, shape, jnp.float32) * scale

    return {
        "x": nrm(ks[0], (BATCH, SEQ, D), 1.0),
        "c": nrm(ks[1], (BATCH, D), 1.0),
        "ctx": nrm(ks[2], (BATCH, CTX_LEN, D), 1.0),
        "c_ctx": nrm(ks[3], (D,), 1.0),
        "w_ada": nrm(ks[4], (DEPTH, D, 6 * D), 0.5 * D ** -0.5),
        "b_ada": nrm(ks[5], (DEPTH, 6 * D), 0.02),
        "norm_pre_mix": 1.0 + nrm(ks[6], (DEPTH, D), 0.05),
        "norm_post_mix": 1.0 + nrm(ks[7], (DEPTH, D), 0.05),
        "norm_pre_ffn": 1.0 + nrm(ks[8], (DEPTH, D), 0.05),
        "norm_post_ffn": 1.0 + nrm(ks[9], (DEPTH, D), 0.05),
        "w_in": nrm(ks[10], (DEPTH, D, IN_WIDTH), D ** -0.5),
        "da_lambda_q1": nrm(ks[11], (DEPTH, DA_HEAD_DIM), 0.1),
        "da_lambda_k1": nrm(ks[12], (DEPTH, DA_HEAD_DIM), 0.1),
        "da_lambda_q2": nrm(ks[13], (DEPTH, DA_HEAD_DIM), 0.1),
        "da_lambda_k2": nrm(ks[14], (DEPTH, DA_HEAD_DIM), 0.1),
        "da_subln": 1.0 + nrm(ks[15], (DEPTH, DA_V_DIM), 0.05),
        "hg_lower_bound": nrm(ks[16], (DEPTH + 1, 2, HG_WIDTH), 0.5),
        "hg_norm": 1.0 + nrm(ks[17], (DEPTH, HG_HEAD_DIM), 0.05),
        "w_out": nrm(ks[18], (DEPTH, MIX_WIDTH, D), MIX_WIDTH ** -0.5),
        "w_router": nrm(ks[19], (DEPTH, D, N_EXPERTS), D ** -0.5),
        "w_gate": nrm(ks[20], (DEPTH, N_EXPERTS, D, EXPERT_FF), D ** -0.5),
        "w_up": nrm(ks[21], (DEPTH, N_EXPERTS, D, EXPERT_FF), D ** -0.5),
        "w_down": nrm(ks[22], (DEPTH, N_EXPERTS, EXPERT_FF, D), EXPERT_FF ** -0.5),
    }


def reference(x, c, ctx, c_ctx, w_ada, b_ada, norm_pre_mix, norm_post_mix, norm_pre_ffn, norm_post_ffn,
              w_in, da_lambda_q1, da_lambda_k1, da_lambda_q2, da_lambda_k2, da_subln, hg_lower_bound,
              hg_norm, w_out, w_router, w_gate, w_up, w_down):
    T = x.shape[1]
    ROWS = T // GRID_W
    cos, sin = axial_rope_tables(ROWS)
    lb_all = jnp.cumsum(jax.nn.softmax(hg_lower_bound.astype(jnp.float32), axis=0), axis=0)
    x_lat, x_ctx = x, ctx
    for l in range(DEPTH):
        last = l == DEPTH - 1
        lambda_init = 0.8 - 0.6 * math.exp(-0.3 * l)
        lam = (jnp.exp(jnp.sum(da_lambda_q1[l].astype(jnp.float32) * da_lambda_k1[l].astype(jnp.float32)))
               - jnp.exp(jnp.sum(da_lambda_q2[l].astype(jnp.float32) * da_lambda_k2[l].astype(jnp.float32)))
               + lambda_init)
        mod_lat = jax.nn.silu(c) @ w_ada[l] + b_ada[l]
        mod_ctx = jax.nn.silu(c_ctx) @ w_ada[l] + b_ada[l]
        sh1, sc1, gt1, sh2, sc2, gt2 = jnp.split(mod_lat[:, None, :], 6, axis=-1)
        csh1, csc1, cgt1, csh2, csc2, cgt2 = jnp.split(mod_ctx, 6, axis=-1)

        h_lat = modulate(rmsnorm(x_lat, norm_pre_mix[l]), sh1, sc1)
        h_ctx = modulate(rmsnorm(x_ctx, norm_pre_mix[l]), csh1, csc1)
        y_lat, y_ctx = token_mixer(h_lat, h_ctx, w_in[l], w_out[l], lam, lambda_init, da_subln[l],
                                   lb_all[l], hg_norm[l], cos, sin, not last)
        x_lat = x_lat + gt1 * rmsnorm(y_lat, norm_post_mix[l])
        h_lat = modulate(rmsnorm(x_lat, norm_pre_ffn[l]), sh2, sc2)
        f_lat = expert_choice_ffn(h_lat, w_router[l], w_gate[l], w_up[l], w_down[l])
        x_lat = x_lat + gt2 * rmsnorm(f_lat, norm_post_ffn[l])
        if not last:
            x_ctx = x_ctx + cgt1 * rmsnorm(y_ctx, norm_post_mix[l])
            h_ctx = modulate(rmsnorm(x_ctx, norm_pre_ffn[l]), csh2, csc2)
            f_ctx = expert_choice_ffn(h_ctx, w_router[l], w_gate[l], w_up[l], w_down[l])
            x_ctx = x_ctx + cgt2 * rmsnorm(f_ctx, norm_post_ffn[l])
    return x_lat
```

```cpp
#include <hip/hip_runtime.h>
#include <cstdio>
#include <cstdint>

#define LAS __attribute__((address_space(3)))
#define GAS __attribute__((address_space(1)))
typedef unsigned short bf16_t;
typedef short bf16x8 __attribute__((ext_vector_type(8)));
typedef short s16x4 __attribute__((ext_vector_type(4)));
typedef float f32x4 __attribute__((ext_vector_type(4)));
typedef float f32x2 __attribute__((ext_vector_type(2)));
typedef float f32x16 __attribute__((ext_vector_type(16)));
typedef unsigned u32x4 __attribute__((ext_vector_type(4)));
typedef unsigned u32x2 __attribute__((ext_vector_type(2)));
typedef unsigned u32x16 __attribute__((ext_vector_type(16)));
typedef GAS unsigned gu32;

constexpr int BATCH = 2, SEQ = 8192, CTXL = 256, DM = 1024, NIN = 4096, NPJ = 3072;
constexpr int RB = CTXL + SEQ;
constexpr int MR = BATCH * RB;
constexpr int ML = BATCH * SEQ;
constexpr int NEXP = 16, CAP = 1024, FFD = 1024;
constexpr float NORM_EPS = 1e-6f;
constexpr float QSCALE = 0.125f * 1.4426950408889634f;
constexpr float LAMBDA_INIT = 0.2f;

constexpr size_t MiB = 1u << 20;
constexpr size_t WS_CTL = 0, CTL_ZERO_BYTES = 1 * MiB;
constexpr size_t WS_MOD = 1 * MiB;
constexpr size_t WS_ROPE = 1 * MiB + 128 * 1024;
constexpr size_t WS_AFF = 2 * MiB;
constexpr size_t WS_SELIDX = 3 * MiB;
constexpr size_t WS_SELGATE = 3 * MiB + 128 * 1024;
constexpr size_t WS_SLOT = 3 * MiB + 512 * 1024;
constexpr size_t WS_HGD = 4 * MiB;
constexpr size_t WS_WIN = 5 * MiB;
constexpr size_t WS_WOUT = 13 * MiB;
constexpr size_t WS_WGU = 15 * MiB;
constexpr size_t WS_X1B = 47 * MiB;
constexpr size_t WS_WD = 79 * MiB;
constexpr size_t WS_PROJ = 111 * MiB;
constexpr size_t WS_KIMG = 210 * MiB;
constexpr size_t WS_VIMG = 210 * MiB + 17301504;
constexpr size_t WS_HN = 243 * MiB;
constexpr size_t WS_END = 276 * MiB;
constexpr size_t WS_YLAT = WS_PROJ;
constexpr size_t WS_HB = WS_PROJ;
constexpr size_t WS_YE = WS_PROJ + 64 * MiB;
constexpr size_t WS_HGU = WS_HN;
constexpr size_t WS_H2 = WS_HN;
constexpr int CW_BAR = 4096;
#ifndef PROBE_PH
#define PROBE_PH -1
#endif

constexpr int RING_BYTES = 143360, LDSCTL_OFF = RING_BYTES, MISC_OFF = LDSCTL_OFF + 320, LDS_BYTES = 147456;
constexpr int NWAVES = 8;

#define LDS_WAIT() asm volatile("s_waitcnt lgkmcnt(0)" ::: "memory")
#define VM_WAIT() asm volatile("s_waitcnt vmcnt(0)" ::: "memory")
#define RLX_AGENT __ATOMIC_RELAXED, __HIP_MEMORY_SCOPE_AGENT

__device__ __forceinline__ unsigned cvt_pk_bf16(float lo, float hi) { unsigned r; asm volatile("v_cvt_pk_bf16_f32 %0, %1, %2" : "=v"(r) : "v"(lo), "v"(hi)); return r; }
__device__ __forceinline__ unsigned cvt4_fp8(float a, float b, float c, float d) { int p = __builtin_amdgcn_cvt_pk_fp8_f32(a, b, 0, false); p = __builtin_amdgcn_cvt_pk_fp8_f32(c, d, p, true); return (unsigned)p; }
__device__ __forceinline__ float sat8(float v) { return __builtin_amdgcn_fmed3f(v, -448.f, 448.f); }
__device__ __forceinline__ unsigned cvt4_fp8_sat(float a, float b, float c, float d) { return cvt4_fp8(sat8(a), sat8(b), sat8(c), sat8(d)); }
constexpr float W8_SCALE = 32.f, W8_INV = 1.f / 32.f;
__device__ __forceinline__ unsigned f2bf(float f) { unsigned u = __builtin_bit_cast(unsigned, f); return (u + 0x7fffu + ((u >> 16) & 1u)) >> 16; }
__device__ __forceinline__ unsigned pk2(float lo, float hi) { return f2bf(lo) | (f2bf(hi) << 16); }
__device__ __forceinline__ float bf2f(unsigned short h) { return __builtin_bit_cast(float, (unsigned)h << 16); }
__device__ __forceinline__ int opaque_tid() { int t = threadIdx.x; asm volatile("" : "+v"(t)); return t; }
template <class T> __device__ __forceinline__ T* launder(T* p) { asm volatile("" : "+v"(p)); return p; }
template <class T> __device__ __forceinline__ GAS T* launder_g(T* p) { GAS T* g = (GAS T*)p; asm volatile("" : "+v"(g)); return g; }
__device__ __forceinline__ float half_sum32(float v) {
    v += __builtin_bit_cast(float, __builtin_amdgcn_update_dpp(0, __builtin_bit_cast(int, v), 0xB1, 0xf, 0xf, false));
    v += __builtin_bit_cast(float, __builtin_amdgcn_update_dpp(0, __builtin_bit_cast(int, v), 0x4E, 0xf, 0xf, false));
    v += __builtin_bit_cast(float, __builtin_amdgcn_update_dpp(0, __builtin_bit_cast(int, v), 0x141, 0xf, 0xf, false));
    v += __builtin_bit_cast(float, __builtin_amdgcn_update_dpp(0, __builtin_bit_cast(int, v), 0x140, 0xf, 0xf, false));
    v += __builtin_bit_cast(float, __builtin_amdgcn_ds_swizzle(__builtin_bit_cast(int, v), 0x401F));
    return v;
}
#define DPPF(x, ctl) __builtin_bit_cast(float, __builtin_amdgcn_update_dpp(0, __builtin_bit_cast(int, (x)), (ctl), 0xf, 0xf, false))
__device__ __forceinline__ float reduce16(const float (&v)[16], int lane) {
    const bool b3 = (lane & 8) != 0, b2 = (lane & 4) != 0, b1 = (lane & 2) != 0, b0 = (lane & 1) != 0;
    float w8[8], w4[4], w2[2];
#pragma unroll
    for (int k = 0; k < 8; ++k) { const float keep = b3 ? v[k + 8] : v[k], send = b3 ? v[k] : v[k + 8]; w8[k] = keep + DPPF(send, 0x140); }
#pragma unroll
    for (int k = 0; k < 4; ++k) { const float keep = b2 ? w8[k + 4] : w8[k], send = b2 ? w8[k] : w8[k + 4]; w4[k] = keep + DPPF(send, 0x141); }
#pragma unroll
    for (int k = 0; k < 2; ++k) { const float keep = b1 ? w4[k + 2] : w4[k], send = b1 ? w4[k] : w4[k + 2]; w2[k] = keep + DPPF(send, 0x4E); }
    const float keep = b0 ? w2[1] : w2[0], send = b0 ? w2[0] : w2[1];
    float r = keep + DPPF(send, 0xB1);
    r += __builtin_bit_cast(float, __builtin_amdgcn_ds_swizzle(__builtin_bit_cast(int, r), 0x401F));
    return r + __shfl_xor(r, 32);
}
__device__ __forceinline__ float row_sum16(float v) { v += DPPF(v, 0xB1); v += DPPF(v, 0x4E); v += DPPF(v, 0x141); v += DPPF(v, 0x140); return v; }
__device__ __forceinline__ float row_max16(float v) { v = fmaxf(v, DPPF(v, 0xB1)); v = fmaxf(v, DPPF(v, 0x4E)); v = fmaxf(v, DPPF(v, 0x141)); v = fmaxf(v, DPPF(v, 0x140)); return v; }
__device__ __forceinline__ unsigned wave_sum_u(unsigned v) {
    v += (unsigned)__builtin_amdgcn_update_dpp(0, (int)v, 0xB1, 0xf, 0xf, false); v += (unsigned)__builtin_amdgcn_update_dpp(0, (int)v, 0x4E, 0xf, 0xf, false);
    v += (unsigned)__builtin_amdgcn_update_dpp(0, (int)v, 0x141, 0xf, 0xf, false); v += (unsigned)__builtin_amdgcn_update_dpp(0, (int)v, 0x140, 0xf, 0xf, false);
    v += (unsigned)__builtin_amdgcn_ds_swizzle((int)v, 0x401F);
    return v + (unsigned)__shfl_xor((int)v, 32);
}
__device__ __forceinline__ float xchg32(float v, bool lo) { unsigned a = __builtin_bit_cast(unsigned, v), b = a; asm volatile("" : "+v"(b)); const auto rr = __builtin_amdgcn_permlane32_swap(a, b, false, false); return __builtin_bit_cast(float, lo ? rr[1] : rr[0]); }
__device__ __forceinline__ float wave_sum(float v) {
    v = half_sum32(v);
    return v + __shfl_xor(v, 32);
}

namespace pg8 {
constexpr int BM = 256, BK = 64, HALF = 128, HTB = HALF * BK * 2, STAGE_BYTES = 8 * HTB, NXCD = 8, WGM = 8;
__host__ __device__ __forceinline__ int lds_byte(int r, int c) { const int st = (r >> 4) * 2 + (c >> 5), rr = r & 15, cc = c & 31, ob = rr * 64 + cc * 2; return st * 1024 + (ob ^ (((ob >> 9) & 1) << 5)); }
__host__ __device__ __forceinline__ void stage_rc(int b, int& R, int& C) { const int st = b / 1024, sb = b % 1024, swz = sb ^ (((sb >> 9) & 1) << 5); R = (st >> 1) * 16 + swz / 64; C = (st & 1) * 32 + (swz % 64) / 2; }
__host__ __device__ __forceinline__ int perm32(int rho) { const int n = rho >> 4, i = rho & 15; return 8 * (i >> 2) + 4 * n + (i & 3); }

struct Unit { int pm, pn, arow0, gadd; const int* gidx; const bf16_t* Bt; int aux; };

typedef int v8i_t __attribute__((ext_vector_type(8)));
typedef v8i_t v8i_a16 __attribute__((aligned(16)));
__device__ __forceinline__ void mma_block8(f32x4 (&c)[4][2], const v8i_t (&At)[4], const v8i_t (&Bt)[2]) {
#pragma unroll
    for (int m = 0; m < 4; ++m)
#pragma unroll
        for (int n = 0; n < 2; ++n) asm volatile("v_mfma_scale_f32_16x16x128_f8f6f4 %0, %1, %2, %0, %3, %3 op_sel_hi:[0,0,0]" : "+v"(c[m][n]) : "v"(Bt[n]), "v"(At[m]), "v"(0x7f7f7f7f));
}
__device__ __forceinline__ void mma_block(f32x4 (&c)[4][2], const bf16x8 (&At)[4][2], const bf16x8 (&Bt)[2][2]) {
#pragma unroll
    for (int m = 0; m < 4; ++m)
#pragma unroll
        for (int n = 0; n < 2; ++n)
#pragma unroll
            for (int k = 0; k < 2; ++k) c[m][n] = __builtin_amdgcn_mfma_f32_16x16x32_bf16(Bt[n][k], At[m][k], c[m][n], 0, 0, 0);
}
template <class Epi, class Sched, bool ALIGN_EPI, bool F8 = false>
__device__ __forceinline__ void gemm_phase(LAS unsigned char* lds, const bf16_t* Abase, int K, const Sched& S, const Epi& E) {
    const int tid = opaque_tid(), wid = __builtin_amdgcn_readfirstlane(tid >> 6), lane = tid & 63, wr = wid >> 2, wc = wid & 3, fr = lane & 15, fq = lane >> 4;
    const int rowb = F8 ? K : 2 * K;
    const int nt = rowb / 128;
    int Rr[2], Cc[2]; unsigned voffB[2];
#pragma unroll
    for (int i = 0; i < 2; ++i) { int R, C; stage_rc(tid * 16 + i * 8192, R, C); const int Rb = Epi::PERM ? ((R & ~31) + perm32(R & 31)) : R;
        Rr[i] = R; Cc[i] = C; voffB[i] = (unsigned)(Rb * rowb + C * 2); }
    const size_t kstep = (size_t)(BK * 2);
    const size_t hstep = (size_t)HALF * rowb;
    const unsigned ldsw = (unsigned)wid * 1024u;
    const int aoff = F8 ? lds_byte(wr * 64 + fr, fq * 16) : lds_byte(wr * 64 + fr, fq * 8), boff = F8 ? lds_byte(wc * 32 + fr, fq * 16) : lds_byte(wc * 32 + fr, fq * 8);
    constexpr int KOFF = F8 ? 16 : 1024;
#define PG8_SA(b, h) (((b) * 2 + (h)) * HTB)
#define PG8_SB(b, h) ((4 + (b) * 2 + (h)) * HTB)
#define PG8_STAGE2(bufoff, gbase, v0, v1) do { \
        __builtin_amdgcn_global_load_lds((const unsigned*)((const char*)(gbase) + (v0)), (LAS unsigned*)(lds + (bufoff) + ldsw), 16, 0, 0); \
        __builtin_amdgcn_global_load_lds((const unsigned*)((const char*)(gbase) + (v1)), (LAS unsigned*)(lds + (bufoff) + ldsw + 8192), 16, 0, 0); } while (0)
#define PG8_STAGEB(bufoff, gbase) PG8_STAGE2(bufoff, gbase, voffB[0], voffB[1])
#define PG8_LDA(dst, b, h) do { if constexpr (F8) { _Pragma("unroll") for (int m = 0; m < 4; ++m) dst##8[m] = *(const LAS v8i_a16*)(lds + PG8_SA(b, h) + aoff + m * 2048); } else { _Pragma("unroll") for (int m = 0; m < 4; ++m) _Pragma("unroll") for (int k = 0; k < 2; ++k) dst[m][k] = *(const LAS bf16x8*)(lds + PG8_SA(b, h) + aoff + m * 2048 + k * KOFF); } } while (0)
#define PG8_LDB(dst, b, h) do { if constexpr (F8) { _Pragma("unroll") for (int n = 0; n < 2; ++n) dst##8[n] = *(const LAS v8i_a16*)(lds + PG8_SB(b, h) + boff + n * 2048); } else { _Pragma("unroll") for (int n = 0; n < 2; ++n) _Pragma("unroll") for (int k = 0; k < 2; ++k) dst[n][k] = *(const LAS bf16x8*)(lds + PG8_SB(b, h) + boff + n * 2048 + k * KOFF); } } while (0)
#define PG8_MMA(ai, bj, At, Bt) do { __builtin_amdgcn_s_setprio(1); if constexpr (F8) mma_block8(acc[ai][bj], At##8, Bt##8); else mma_block(acc[ai][bj], At, Bt); __builtin_amdgcn_s_setprio(0); } while (0)
#define PG8_WAIT_V(n) asm volatile("s_waitcnt vmcnt(" #n ")" ::: "memory")
#define PG8_WAIT_L(n) asm volatile("s_waitcnt lgkmcnt(" #n ")" ::: "memory")
#define PG8_BAR __builtin_amdgcn_s_barrier()
#define PG8_SCHED __builtin_amdgcn_sched_barrier(0)
#define PG8_AOFF(u, VA) do { _Pragma("unroll") for (int h_ = 0; h_ < 2; ++h_) _Pragma("unroll") for (int i_ = 0; i_ < 2; ++i_) { const int rl_ = h_ * HALF + Rr[i_]; \
        const int gr_ = (u).gidx ? ((u).gadd + (u).gidx[rl_]) : ((u).arow0 + rl_); VA[h_][i_] = (unsigned)(gr_ * rowb + Cc[i_] * 2); } } while (0)
    Unit cur, nxt; int ui = 0;
    if (!S.next(0, cur)) return;
    f32x4 acc[2][2][4][2];
#pragma unroll
    for (int a = 0; a < 2; ++a)
#pragma unroll
        for (int b = 0; b < 2; ++b)
#pragma unroll
            for (int m = 0; m < 4; ++m)
#pragma unroll
                for (int n = 0; n < 2; ++n) acc[a][b][m][n] = (f32x4){0.f, 0.f, 0.f, 0.f};
    bf16x8 At[4][2], B0[2][2], B1[2][2]; v8i_t At8[4], B08[2], B18[2];
    unsigned cVA[2][2], nVA[2][2];
    PG8_AOFF(cur, cVA);
    const char* const A0 = (const char*)Abase;
    const char* cB = (const char*)cur.Bt;
    PG8_STAGEB(PG8_SB(0, 0), cB); PG8_STAGEB(PG8_SB(0, 1), cB + hstep); PG8_STAGE2(PG8_SA(0, 0), A0, cVA[0][0], cVA[0][1]); PG8_STAGE2(PG8_SA(0, 1), A0, cVA[1][0], cVA[1][1]);
    if (wr == 1) PG8_BAR;
    PG8_WAIT_V(2); PG8_BAR;
    PG8_STAGEB(PG8_SB(1, 0), cB + kstep); PG8_STAGE2(PG8_SA(1, 0), A0 + kstep, cVA[0][0], cVA[0][1]); PG8_STAGEB(PG8_SB(1, 1), cB + hstep + kstep);
    PG8_WAIT_V(6); PG8_BAR;
    for (;;) {
        const bool has_next = S.next(ui + 1, nxt);
        const char* nB = has_next ? (const char*)nxt.Bt : cB;
        if (has_next) { PG8_AOFF(nxt, nVA); } else {
#pragma unroll
            for (int h_ = 0; h_ < 2; ++h_)
#pragma unroll
                for (int i_ = 0; i_ < 2; ++i_) nVA[h_][i_] = cVA[h_][i_]; }
        for (int t = 0; t < nt; t += 2) {
            const bool last = (t == nt - 2);
            const char* a1 = A0 + (size_t)(t + 1) * kstep;
            const char* a2 = last ? A0 : A0 + (size_t)(t + 2) * kstep; const char* b2 = last ? nB : cB + (size_t)(t + 2) * kstep;
            const char* a3 = a2 + kstep; const char* b3 = b2 + kstep;
            const unsigned x00 = last ? nVA[0][0] : cVA[0][0], x01 = last ? nVA[0][1] : cVA[0][1], x10 = last ? nVA[1][0] : cVA[1][0], x11 = last ? nVA[1][1] : cVA[1][1];
            PG8_LDB(B0, 0, 0); PG8_LDB(B1, 0, 1); PG8_SCHED; PG8_LDA(At, 0, 0); PG8_STAGE2(PG8_SA(1, 1), a1, cVA[1][0], cVA[1][1]);
            PG8_WAIT_V(8); PG8_WAIT_L(0); PG8_BAR; PG8_MMA(0, 0, At, B0); PG8_MMA(0, 1, At, B1); PG8_BAR; PG8_SCHED;
            PG8_LDA(At, 0, 1); PG8_STAGEB(PG8_SB(0, 0), b2); PG8_STAGEB(PG8_SB(0, 1), b2 + hstep); PG8_STAGE2(PG8_SA(0, 0), a2, x00, x01);
            PG8_WAIT_V(8); PG8_WAIT_L(0); PG8_BAR; PG8_MMA(1, 0, At, B0); PG8_MMA(1, 1, At, B1); PG8_BAR; PG8_SCHED;
            PG8_LDB(B0, 1, 0); PG8_LDB(B1, 1, 1); PG8_SCHED; PG8_LDA(At, 1, 0); PG8_STAGE2(PG8_SA(0, 1), a2, x10, x11);
            PG8_WAIT_V(8); PG8_WAIT_L(0); PG8_BAR; PG8_MMA(0, 0, At, B0); PG8_MMA(0, 1, At, B1); PG8_BAR; PG8_SCHED;
            PG8_LDA(At, 1, 1); PG8_STAGEB(PG8_SB(1, 0), b3); PG8_STAGEB(PG8_SB(1, 1), b3 + hstep); PG8_STAGE2(PG8_SA(1, 0), a3, x00, x01);
            PG8_WAIT_V(8); PG8_WAIT_L(0); PG8_BAR; PG8_MMA(1, 0, At, B0); PG8_MMA(1, 1, At, B1); PG8_BAR; PG8_SCHED;
        }
        if constexpr (ALIGN_EPI) { if (wr == 0) PG8_BAR; }
        if constexpr (F8) asm volatile("s_nop 15\n\ts_nop 15" ::: "memory");
        E(acc, cur, wr, wc, fr, fq);
        if (!has_next) break;
#pragma unroll
        for (int a = 0; a < 2; ++a)
#pragma unroll
            for (int b = 0; b < 2; ++b)
#pragma unroll
                for (int m = 0; m < 4; ++m)
#pragma unroll
                    for (int n = 0; n < 2; ++n) acc[a][b][m][n] = (f32x4){0.f, 0.f, 0.f, 0.f};
        cur = nxt; cB = nB; ++ui;
#pragma unroll
        for (int h_ = 0; h_ < 2; ++h_)
#pragma unroll
            for (int i_ = 0; i_ < 2; ++i_) cVA[h_][i_] = nVA[h_][i_];
        if constexpr (ALIGN_EPI) { if (wr == 1) PG8_BAR; }
    }
    PG8_WAIT_V(0);
    if constexpr (!ALIGN_EPI) { if (wr == 0) PG8_BAR; }
    PG8_BAR;
#undef PG8_SA
#undef PG8_SB
#undef PG8_STAGE2
#undef PG8_STAGEB
#undef PG8_LDA
#undef PG8_LDB
#undef PG8_MMA
#undef PG8_WAIT_V
#undef PG8_WAIT_L
#undef PG8_BAR
#undef PG8_SCHED
#undef PG8_AOFF
}
}

#define XB_TMO      128
#define XB_XCNT(j)  (256  + 64 * (j))
#define XB_XSUB(j)  (1280 + 64 * (j))
#define XB_XGEN(j)  (2304 + 64 * (j))
#define XB_TOP      3328
#define XB_TOPGEN   3392
#define XCD_BAR_WORDS 3456
#define XB_SPIN_CAP (1u << 22)
__device__ __forceinline__ unsigned xb_ld(unsigned* p)              { return __hip_atomic_load(p, __ATOMIC_RELAXED, __HIP_MEMORY_SCOPE_AGENT); }
__device__ __forceinline__ unsigned xb_add(unsigned* p, unsigned v) { return __hip_atomic_fetch_add(p, v, __ATOMIC_RELAXED, __HIP_MEMORY_SCOPE_AGENT); }
__device__ __forceinline__ unsigned xb_xcc_id() { return (unsigned)__builtin_amdgcn_s_getreg((3 << 11) | 20) & 0xFu; }
#define XB_SPIN(cond, bar) do { unsigned _sp = 0; while (cond) { __builtin_amdgcn_s_sleep(1); \
    if ((++_sp & 255u) == 0u) { if (xb_ld(&(bar)[XB_TMO])) break; if (_sp > XB_SPIN_CAP) { atomicAdd(&(bar)[XB_TMO], 1u); break; } } } } while (0)
struct XcdBarrier { unsigned* bar; unsigned x; volatile LAS unsigned* st; };
__device__ __forceinline__ XcdBarrier xcd_barrier_post(unsigned* bar, volatile LAS unsigned* st) {
    XcdBarrier b; b.bar = bar; b.x = xb_xcc_id(); b.st = st;
    if (threadIdx.x == 0) (void)xb_add(&bar[XB_XCNT(b.x)], 1u);
    return b;
}
__device__ __forceinline__ void xcd_barrier_complete(unsigned* bar, unsigned x, unsigned& nloc, unsigned& nx) {
    const unsigned G = gridDim.x * gridDim.y * gridDim.z;
    unsigned sum, cnt, mine, sp = 0u;
    for (;;) {
        sum = 0u; cnt = 0u; mine = 0u;
#pragma unroll
        for (unsigned j = 0; j < 16; ++j) { const unsigned c = xb_ld(&bar[XB_XCNT(j)]); sum += c; cnt += (c > 0u) ? 1u : 0u; mine = (j == x) ? c : mine; }
        if (sum == G) break;
        __builtin_amdgcn_s_sleep(1);
        if ((++sp & 255u) == 0u) { if (xb_ld(&bar[XB_TMO])) break; if (sp > XB_SPIN_CAP) { atomicAdd(&bar[XB_TMO], 1u); break; } }
    }
    nloc = mine > 0u ? mine : 1u; nx = cnt > 0u ? cnt : 1u;
}
__device__ __forceinline__ void xcd_barrier(const XcdBarrier& b) {
    asm volatile("s_waitcnt vmcnt(0)" ::: "memory");
    __syncthreads();
    if (threadIdx.x == 0) {
        unsigned* bar = b.bar;
        __builtin_amdgcn_s_waitcnt(0);
        unsigned nloc = b.st[0], nx = b.st[1];
        if (nloc == 0u) { xcd_barrier_complete(bar, b.x, nloc, nx); b.st[0] = nloc; b.st[1] = nx; }
        const unsigned old = xb_add(&bar[XB_XSUB(b.x)], 1u);
        const unsigned gen = old / nloc;
        if (old + 1u == (gen + 1u) * nloc) {
            __builtin_amdgcn_fence(__ATOMIC_RELEASE, "agent");
            asm volatile("s_waitcnt vmcnt(0)" ::: "memory");
            const unsigned og = xb_add(&bar[XB_TOP], 1u);
            const unsigned tg = og / nx;
            if (og + 1u == (tg + 1u) * nx) xb_add(&bar[XB_TOPGEN], 1u);
            else XB_SPIN(xb_ld(&bar[XB_TOPGEN]) == tg, bar);
            __builtin_amdgcn_fence(__ATOMIC_ACQUIRE, "agent");
            xb_add(&bar[XB_XGEN(b.x)], 1u);
            asm volatile("s_waitcnt vmcnt(0)" ::: "memory");
        } else {
            XB_SPIN(xb_ld(&bar[XB_XGEN(b.x)]) == gen, bar);
            __builtin_amdgcn_fence(__ATOMIC_ACQUIRE, "agent");
            asm volatile("s_waitcnt vmcnt(0)" ::: "memory");
        }
    }
    __syncthreads();
}

struct Args {
    const float* x; const float* c; const float* ctx; const float* c_ctx; const float* w_ada; const float* b_ada;
    const float* n_pre_mix; const float* n_post_mix; const float* n_pre_ffn; const float* n_post_ffn;
    const float* w_in; const float* lq1; const float* lk1; const float* lq2; const float* lk2; const float* da_subln;
    const float* hglb; const float* hg_norm; const float* w_out; const float* w_router; const float* w_gate; const float* w_up; const float* w_down;
    float* out; unsigned char* ws; int ph_lo, ph_hi;
};

struct Frame {
    LAS unsigned char* lds; volatile LAS unsigned* MISC; gu32* ctl;
    int tid, lane, wave, vcu, G;
};

struct P0Item { const float* W; bf16_t* WT; int drow0; int ilv; int r; };
__device__ __forceinline__ void p0_item_load(const float* W, int N, int item, int lane, float (&wv)[32]) {
    const int nblk = N / 32, kb = item / nblk, nb = item % nblk, k0 = 64 * kb, n0 = 32 * nb;
    const GAS float* p = (const GAS float*)(W + (size_t)(k0 + (lane >> 5)) * N + n0 + (lane & 31));
#pragma unroll
    for (int i = 0; i < 32; ++i) wv[i] = p[(size_t)(2 * i) * N];
}
__device__ __forceinline__ void p0_item_store8(const float (&wv)[32], int K, int N, unsigned char* WT, int drow0, bool ilv, LAS float* scr, int item, int lane) {
    const int nblk = N / 32, kb = item / nblk, nb = item % nblk, k0 = 64 * kb, n0 = 32 * nb;
#pragma unroll
    for (int i = 0; i < 32; ++i) scr[(2 * i + (lane >> 5)) * 33 + (lane & 31)] = wv[i];
    LDS_WAIT(); asm volatile("" ::: "memory");
    const int c = lane & 7;
    const int dr = drow0 + (ilv ? ((n0 >> 7) * 256 + (n0 & 127)) : n0);
#pragma unroll
    for (int j = 0; j < 4; ++j) { const int n = (lane >> 3) + 8 * j; const LAS float* s = scr + (8 * c) * 33 + n;
        u32x2 o; o.x = cvt4_fp8(s[0 * 33] * W8_SCALE, s[1 * 33] * W8_SCALE, s[2 * 33] * W8_SCALE, s[3 * 33] * W8_SCALE); o.y = cvt4_fp8(s[4 * 33] * W8_SCALE, s[5 * 33] * W8_SCALE, s[6 * 33] * W8_SCALE, s[7 * 33] * W8_SCALE);
        *(GAS u32x2*)(WT + (size_t)(dr + n) * K + k0 + 8 * c) = o; }
    LDS_WAIT(); asm volatile("" ::: "memory");
}
__device__ __forceinline__ void p0_item_store(const float (&wv)[32], int K, int N, bf16_t* WT, int drow0, bool ilv, LAS float* scr, int item, int lane) {
    const int nblk = N / 32, kb = item / nblk, nb = item % nblk, k0 = 64 * kb, n0 = 32 * nb;
#pragma unroll
    for (int i = 0; i < 32; ++i) scr[(2 * i + (lane >> 5)) * 33 + (lane & 31)] = wv[i];
    LDS_WAIT(); asm volatile("" ::: "memory");
    const int c = lane & 7;
    const int dr = drow0 + (ilv ? ((n0 >> 7) * 256 + (n0 & 127)) : n0);
#pragma unroll
    for (int j = 0; j < 4; ++j) { const int n = (lane >> 3) + 8 * j; const LAS float* s = scr + (8 * c) * 33 + n;
        u32x4 o; o.x = cvt_pk_bf16(s[0 * 33], s[1 * 33]); o.y = cvt_pk_bf16(s[2 * 33], s[3 * 33]); o.z = cvt_pk_bf16(s[4 * 33], s[5 * 33]); o.w = cvt_pk_bf16(s[6 * 33], s[7 * 33]);
        *(GAS u32x4*)(WT + (size_t)(dr + n) * K + k0 + 8 * c) = o; }
    LDS_WAIT(); asm volatile("" ::: "memory");
}

__device__ __forceinline__ float silu_f(float v) { return v * __builtin_amdgcn_rcpf(1.f + __expf(-v)); }

constexpr int P0_I_IN = 16 * 128, P0_I_OUT = 16 * 32, P0_I_E = 16 * 32;
constexpr int P0_ITEMS_EARLY = P0_I_IN + P0_I_OUT + 2 * NEXP * P0_I_E, P0_ITEMS_ALL = P0_I_IN + P0_I_OUT + 3 * NEXP * P0_I_E;
__device__ __forceinline__ void convert_items(Frame& F, const Args& a, int lo, int hi, int gw, int NGW, int wave_, int lane_) {
    LAS float* scr = (LAS float*)(F.lds + wave_ * 16384);
    constexpr int I_IN = P0_I_IN, I_OUT = P0_I_OUT, I_E = P0_I_E;
    const int NITEMS = hi;
    bf16_t* win_t = (bf16_t*)(a.ws + WS_WIN); bf16_t* wout_t = (bf16_t*)(a.ws + WS_WOUT); unsigned char* wgu_t = a.ws + WS_WGU; unsigned char* wd_t = a.ws + WS_WD;
#define P0_DECODE(it_, W_, N_, WT_, D0_, ILV_, R_) do { int r_ = (it_); \
        if (r_ < I_IN) { W_ = a.w_in; N_ = 4096; WT_ = (unsigned char*)win_t; D0_ = 0; ILV_ = 0; R_ = r_; } \
        else if ((r_ -= I_IN) < I_OUT) { W_ = a.w_out; N_ = 1024; WT_ = (unsigned char*)wout_t; D0_ = 0; ILV_ = 0; R_ = r_; } \
        else { r_ -= I_OUT; const int mat_ = r_ / (NEXP * I_E); r_ -= mat_ * (NEXP * I_E); const int e_ = r_ / I_E; r_ -= e_ * I_E; N_ = 1024; R_ = r_; \
            if (mat_ == 0) { W_ = a.w_gate + (size_t)e_ * 1048576; WT_ = wgu_t + (size_t)e_ * 2097152; D0_ = 0; ILV_ = 3; } \
            else if (mat_ == 1) { W_ = a.w_up + (size_t)e_ * 1048576; WT_ = wgu_t + (size_t)e_ * 2097152; D0_ = 128; ILV_ = 3; } \
            else { W_ = a.w_down + (size_t)e_ * 1048576; WT_ = wd_t + (size_t)e_ * 1048576; D0_ = 0; ILV_ = 2; } } } while (0)
#define P0_STORE(wv_, N_, WT_, D0_, ILV_, R_) do { if ((ILV_) & 2) p0_item_store8(wv_, 1024, N_, WT_, D0_, ((ILV_) & 1) != 0, scr, R_, lane_); else p0_item_store(wv_, 1024, N_, (bf16_t*)(WT_), D0_, false, scr, R_, lane_); } while (0)
    float wa[32], wb[32];
    const float* Wc; int Nc; unsigned char* WTc; int D0c; int ILVc; int Rc;
    int it = lo + gw;
    if (it < NITEMS) { P0_DECODE(it, Wc, Nc, WTc, D0c, ILVc, Rc); p0_item_load(Wc, Nc, Rc, lane_, wa); }
    while (it < NITEMS) {
        const int it1 = it + NGW; const float* W1 = Wc; int N1 = Nc; unsigned char* WT1 = WTc; int D01 = D0c; int ILV1 = ILVc; int R1 = Rc;
        if (it1 < NITEMS) { P0_DECODE(it1, W1, N1, WT1, D01, ILV1, R1); p0_item_load(W1, N1, R1, lane_, wb); }
        P0_STORE(wa, Nc, WTc, D0c, ILVc, Rc);
        if (it1 >= NITEMS) break;
        const int it2 = it1 + NGW;
        if (it2 < NITEMS) { P0_DECODE(it2, Wc, Nc, WTc, D0c, ILVc, Rc); p0_item_load(Wc, Nc, Rc, lane_, wa); }
        P0_STORE(wb, N1, WT1, D01, ILV1, R1);
        it = it2;
    }
#undef P0_DECODE
#undef P0_STORE
}

__device__ __forceinline__ void p0_prologue(Frame& F, const Args& a) {
    const int tid_ = opaque_tid(), lane_ = tid_ & 63; const int wave_ = __builtin_amdgcn_readfirstlane(tid_ >> 6);
    if (blockIdx.x < 96) {
        LAS float* sv = (LAS float*)(F.lds);
        LAS float* part = (LAS float*)(F.lds + 16384);
        for (int i = tid_; i < 3072; i += 512) { const int j = i >> 10, k = i & 1023; const float v = (j < 2) ? a.c[j * 1024 + k] : a.c_ctx[k]; sv[i] = silu_f(v); }
        __syncthreads();
        const int col = blockIdx.x * 64 + lane_; const int kb = wave_ * 128;
        float s0 = 0.f, s1 = 0.f, s2 = 0.f;
#pragma unroll 1
        for (int k0 = 0; k0 < 128; k0 += 32) {
            float w[32];
#pragma unroll
            for (int k = 0; k < 32; ++k) w[k] = a.w_ada[(size_t)(kb + k0 + k) * 6144 + col];
#pragma unroll
            for (int k = 0; k < 32; ++k) { s0 += sv[kb + k0 + k] * w[k]; s1 += sv[1024 + kb + k0 + k] * w[k]; s2 += sv[2048 + kb + k0 + k] * w[k]; }
        }
        part[(wave_ * 3 + 0) * 64 + lane_] = s0; part[(wave_ * 3 + 1) * 64 + lane_] = s1; part[(wave_ * 3 + 2) * 64 + lane_] = s2;
        __syncthreads();
        if (tid_ < 192) { const int j = tid_ >> 6, l = tid_ & 63; float s = a.b_ada[blockIdx.x * 64 + l];
#pragma unroll
            for (int w = 0; w < 8; ++w) s += part[(w * 3 + j) * 64 + l];
            ((float*)(a.ws + WS_MOD))[j * 6144 + blockIdx.x * 64 + l] = s; }
        __syncthreads();
    } else if (blockIdx.x == 96) {
        for (int e = tid_; e < 2048; e += 512) { const int pos = e >> 4, j = e & 15;
            const double inv = exp(-(double)j * (1.0 / 16.0) * 9.210340371976184); const double ang = (double)pos * inv;
            f32x2 v; v.x = (float)cos(ang); v.y = (float)sin(ang); ((f32x2*)(a.ws + WS_ROPE))[e] = v; }
    }
    convert_items(F, a, 0, P0_ITEMS_EARLY, F.vcu * NWAVES + wave_, F.G * NWAVES, wave_, lane_);
}

__device__ __forceinline__ void p1_norm(Frame& F, const Args& a) {
    const int tid_ = opaque_tid(), lane_ = tid_ & 63; const int wave_ = __builtin_amdgcn_readfirstlane(tid_ >> 6);
    LAS float* par = (LAS float*)F.lds;
    const float* mod = (const float*)(a.ws + WS_MOD);
    for (int i = tid_; i < 3072; i += 512) { const int v = i >> 10, c = i & 1023;
        par[v * 2048 + c] = a.n_pre_mix[c] * (1.f + mod[v * 6144 + 1024 + c]); par[v * 2048 + 1024 + c] = mod[v * 6144 + c]; }
    __syncthreads();
    bf16_t* hn = (bf16_t*)(a.ws + WS_HN);
    const bool cwg = false;
    const int gw = (int)blockIdx.x * NWAVES + wave_, NGW = F.G * NWAVES;
    const int nrows = MR;
    for (int q0 = gw; q0 < nrows; q0 += 2 * NGW) {
        const int q1 = q0 + NGW; const bool v1 = q1 < nrows;
        int Rr[2]; const float* srcp[2]; int var[2];
#pragma unroll
        for (int u = 0; u < 2; ++u) { const int q = (u == 0 || v1) ? (u ? q1 : q0) : q0;
            const int R = q; (void)cwg;
            const int b = R >= RB ? 1 : 0, rr = R - b * RB; const bool isctx = rr < CTXL;
            Rr[u] = R; srcp[u] = isctx ? a.ctx + (size_t)(b * CTXL + rr) * DM : a.x + (size_t)(b * SEQ + rr - CTXL) * DM; var[u] = isctx ? 2 : b; }
        f32x4 xv[2][4]; float ss[2] = {0.f, 0.f};
#pragma unroll
        for (int u = 0; u < 2; ++u) { const GAS f32x4* xr = (const GAS f32x4*)srcp[u] + lane_;
#pragma unroll
            for (int j = 0; j < 4; ++j) xv[u][j] = xr[64 * j]; }
#pragma unroll
        for (int u = 0; u < 2; ++u)
#pragma unroll
            for (int j = 0; j < 4; ++j) ss[u] += (xv[u][j].x * xv[u][j].x + xv[u][j].y * xv[u][j].y) + (xv[u][j].z * xv[u][j].z + xv[u][j].w * xv[u][j].w);
        ss[0] = wave_sum(ss[0]); ss[1] = wave_sum(ss[1]);
#pragma unroll
        for (int u = 0; u < 2; ++u) { if (u == 1 && !v1) break;
            const float rstd = __builtin_amdgcn_rsqf(ss[u] * (1.f / DM) + NORM_EPS);
            GAS unsigned long long* o8 = (GAS unsigned long long*)(hn + (size_t)Rr[u] * DM) + lane_;
#pragma unroll
            for (int j = 0; j < 4; ++j) { const int c = 4 * lane_ + 256 * j;
                const f32x4 sc = *(const LAS f32x4*)(par + var[u] * 2048 + c), sh = *(const LAS f32x4*)(par + var[u] * 2048 + 1024 + c);
                const f32x4 h = xv[u][j] * rstd * sc + sh;
                o8[64 * j] = (unsigned long long)cvt_pk_bf16(h.x, h.y) | ((unsigned long long)cvt_pk_bf16(h.z, h.w) << 32); } }
    }
    __syncthreads();
}

struct SchedInProj {
    int nM, nN, nwg, G, c; const bf16_t* Bt; int K;
    __device__ bool next(int i, pg8::Unit& u) const {
        const long L = (long)i * G + c; if (L >= nwg) return false;
        int wgid = (int)L; { const int q = nwg / 8, r = nwg % 8, xcd = wgid % 8, off = wgid / 8; wgid = (xcd < r ? xcd * (q + 1) : r * (q + 1) + (xcd - r) * q) + off; }
        const int nig = 8 * nN, gid = wgid / nig, fm = gid * 8, gsz = (nM - fm) < 8 ? (nM - fm) : 8;
        const int lt = fm + ((wgid % nig) % gsz);
        u.pm = lt + 1 + (lt >= 32 ? 1 : 0); u.pn = (wgid % nig) / gsz; u.arow0 = u.pm * 256; u.gadd = 0; u.gidx = nullptr; u.Bt = Bt + (size_t)u.pn * 256 * K; u.aux = 0; return true;
    }
};
struct EpiInProj {
    static constexpr bool PERM = true;
    bf16_t* P; bf16_t* KI; bf16_t* VI; const f32x2* cs; const float* hglb;
    __device__ __forceinline__ void operator()(const f32x4 (&acc)[2][2][4][2], const pg8::Unit& u, int wr, int wc, int fr, int fq) const {
        const int region = u.pn >> 1;
        const int b = (u.pm >= 33) ? 1 : 0; const bool isctx = (u.pm == 0 || u.pm == 33);
        if (isctx && (region == 0 || region >= 6)) return;
        const int pcol = (region == 0 ? u.pn * 256 : u.pn * 256 - 1024) + wc * 32 + 8 * fq;
        float lbv[2][8];
        if (region == 3 || region == 4) {
            const int d = region - 3;
#pragma unroll
            for (int bj = 0; bj < 2; ++bj) { const int cc = (u.pn & 1) * 256 + bj * 128 + wc * 32 + 8 * fq;
#pragma unroll
                for (int n = 0; n < 2; ++n) { const f32x4 a0 = *(const f32x4*)(hglb + d * 512 + cc + 4 * n), a1 = *(const f32x4*)(hglb + 1024 + d * 512 + cc + 4 * n);
#pragma unroll
                    for (int i = 0; i < 4; ++i) lbv[bj][4 * n + i] = __builtin_amdgcn_rcpf(1.f + __expf(a1[i] - a0[i])); } }
        }
        const float rsign = (fq < 2) ? -1.f : 1.f;
#pragma unroll
        for (int ai = 0; ai < 2; ++ai)
#pragma unroll
            for (int m = 0; m < 4; ++m) {
                const int R = u.pm * 256 + ai * 128 + wr * 64 + m * 16 + fr;
                const int rr = R - b * RB, t = rr - CTXL;
#pragma unroll
                for (int bj = 0; bj < 2; ++bj) {
                    float v[8];
#pragma unroll
                    for (int i = 0; i < 4; ++i) { v[i] = acc[ai][bj][m][0][i]; v[4 + i] = acc[ai][bj][m][1][i]; }
                    if (region <= 1) {
                        if (!isctx) {
                            const int pos = (wc & 1) ? (t & 63) : (t >> 6);
                            const f32x4* cp = (const f32x4*)(cs + pos * 16 + 8 * (fq & 1));
                            const f32x4 c0 = cp[0], c1 = cp[1], c2 = cp[2], c3 = cp[3];
                            const float co[8] = {c0.x, c0.z, c1.x, c1.z, c2.x, c2.z, c3.x, c3.z}, si[8] = {c0.y, c0.w, c1.y, c1.w, c2.y, c2.w, c3.y, c3.w};
#pragma unroll
                            for (int i = 0; i < 8; ++i) { const float pv = xchg32(v[i], fq < 2); v[i] = v[i] * co[i] + rsign * pv * si[i]; }
                        }
                        if (region == 0) {
#pragma unroll
                            for (int i = 0; i < 8; ++i) v[i] *= QSCALE; }
                    } else if (region == 3 || region == 4) {
#pragma unroll
                        for (int i = 0; i < 8; ++i) { const float lb = lbv[bj][i]; const float sg = __builtin_amdgcn_rcpf(1.f + __expf(-v[i])); v[i] = __builtin_amdgcn_logf(lb + (1.f - lb) * sg); }
                    } else if (region == 7) {
#pragma unroll
                        for (int i = 0; i < 8; ++i) v[i] = silu_f(v[i]);
                    }
                    u32x4 w; w.x = cvt_pk_bf16(v[0], v[1]); w.y = cvt_pk_bf16(v[2], v[3]); w.z = cvt_pk_bf16(v[4], v[5]); w.w = cvt_pk_bf16(v[6], v[7]);
                    if (region == 1) {
                        *(u32x4*)(KI + ((size_t)((b * 4 + (u.pn & 1) * 2 + bj) * 132 + (rr >> 6))) * 8192 + ((wc >> 1) * 8 + (wc & 1) * 4 + fq) * 512 + (rr & 63) * 8) = w;
                    } else if (region == 2) {
                        *(u32x4*)(VI + ((size_t)((b * 4 + (u.pn & 1) * 2 + bj) * 132 + (rr >> 6))) * 8192 + wc * 2048 + (rr & 63) * 32 + 8 * fq) = w;
                    } else *(u32x4*)(P + (size_t)R * NPJ + pcol + bj * 128) = w;
                }
            }
    }
};


namespace att {
constexpr int KSTR = 1040, KCOMP = 8 * KSTR, KBUF = 2 * KCOMP, VDB = 4160, VBUF = 4 * VDB, BUF = KBUF + VBUF;
constexpr int WSF_OFF = 2 * BUF;
__device__ __forceinline__ int crow(int r, int hi) { return (r & 3) + 8 * (r >> 2) + 4 * hi; }
__device__ __forceinline__ s16x4 vtr(LAS unsigned char* p) { typedef short v4i16_t __attribute__((ext_vector_type(4))); return __builtin_bit_cast(s16x4, __builtin_amdgcn_ds_read_tr16_b64_v4i16((LAS v4i16_t*)p)); }
#define MFMA32(a, b, c) __builtin_amdgcn_mfma_f32_32x32x16_bf16(a, b, c, 0, 0, 0)

}


namespace hg {
using att::vtr; using att::crow;
constexpr int COL_LF = 512, COL_V = 1536, COL_Q = 2048, COL_G = 2560;
constexpr int BS1 = 256 * 64;
constexpr int H1_K = 0, H1_V = 4 * BS1, H1_TOT = 8 * BS1;
#define HBAR() do { asm volatile("s_waitcnt lgkmcnt(0)" ::: "memory"); __builtin_amdgcn_s_barrier(); asm volatile("" ::: "memory"); } while (0)
__device__ __forceinline__ int seq_pos_to_sc(int dir, int p) { return (dir == 0 || p == 0) ? p : 33 - p; }

struct H1Regs { u32x16 lfa, lfb; u32x16 va, vb; };
__device__ __forceinline__ void h1_load(const bf16_t* P, int unit, int tid, H1Regs& R) {
    const int seq = unit >> 5, p = unit & 31, dir = seq & 1, h = (seq >> 1) & 3, b = seq >> 3;
    const int sc = seq_pos_to_sc(dir, p);
    const bf16_t* Pr = P + (size_t)(b * RB + sc * 256) * NPJ;
    const GAS char* bl = (const GAS char*)(Pr + COL_LF + dir * 512 + h * 128);
    unsigned off = (unsigned)(((tid >> 6) * 32) * NPJ + 2 * (tid & 63)) * 2u;
#pragma unroll
    for (int i = 0; i < 16; ++i) { R.lfa[i] = *(const GAS unsigned*)(bl + off); off += (unsigned)NPJ * 2u; asm volatile("" : "+v"(off)); }
#pragma unroll
    for (int i = 0; i < 16; ++i) { R.lfb[i] = *(const GAS unsigned*)(bl + off); off += (unsigned)NPJ * 2u; asm volatile("" : "+v"(off)); }
    const GAS char* bv = (const GAS char*)(Pr + COL_V + h * 128);
    unsigned voff = (unsigned)((tid >> 4) * NPJ + (tid & 15) * 8) * 2u;
#pragma unroll
    for (int i = 0; i < 4; ++i) { const u32x4 t_ = *(const GAS u32x4*)(bv + voff); R.va[4 * i] = t_.x; R.va[4 * i + 1] = t_.y; R.va[4 * i + 2] = t_.z; R.va[4 * i + 3] = t_.w; voff += 32u * (unsigned)NPJ * 2u; asm volatile("" : "+v"(voff)); }
#pragma unroll
    for (int i = 0; i < 4; ++i) { const u32x4 t_ = *(const GAS u32x4*)(bv + voff); R.vb[4 * i] = t_.x; R.vb[4 * i + 1] = t_.y; R.vb[4 * i + 2] = t_.z; R.vb[4 * i + 3] = t_.w; voff += 32u * (unsigned)NPJ * 2u; asm volatile("" : "+v"(voff)); }
}
__device__ __forceinline__ void h1_phase(LAS unsigned char* lds, const bf16_t* P, float* U, float* Dv, int first, int stride) {
    const int tid = opaque_tid(), lane = tid & 63, hh = lane >> 5, r32 = lane & 31; const int wid = __builtin_amdgcn_readfirstlane(tid >> 6);
    if (first >= 512) return;
    H1Regs R; h1_load(P, first, tid, R);
#pragma unroll 1
    for (int unit = first; unit < 512; unit += stride) {
        const int dir = (unit >> 5) & 1;
#pragma unroll
        for (int i = 0; i < 8; ++i) { const int pc = tid + 512 * i, s = pc >> 4, j = pc & 15;
            const u32x4 t_ = i < 4 ? (u32x4){R.va[4 * i], R.va[4 * i + 1], R.va[4 * i + 2], R.va[4 * i + 3]} : (u32x4){R.vb[4 * (i - 4)], R.vb[4 * (i - 4) + 1], R.vb[4 * (i - 4) + 2], R.vb[4 * (i - 4) + 3]};
            *(LAS u32x4*)(lds + H1_V + (j >> 2) * BS1 + s * 64 + (j & 3) * 16) = t_; }
        const int k = 2 * (tid & 63), rg = tid >> 6;
        float tota = 0.f, totb = 0.f;
#pragma unroll
        for (int i = 0; i < 16; ++i) { tota += __builtin_bit_cast(float, R.lfa[i] << 16) + __builtin_bit_cast(float, R.lfb[i] << 16); totb += __builtin_bit_cast(float, R.lfa[i] & 0xffff0000u) + __builtin_bit_cast(float, R.lfb[i] & 0xffff0000u); }
        LAS float* totl = (LAS float*)(lds + H1_TOT);
        *(LAS f32x2*)(totl + rg * 128 + k) = (f32x2){tota, totb};
        HBAR();
        float basea = 0.f, baseb = 0.f, alla = 0.f, allb = 0.f;
#pragma unroll
        for (int g = 0; g < 8; ++g) { const f32x2 tg = *(const LAS f32x2*)(totl + g * 128 + k); alla += tg.x; allb += tg.y; basea += (g < rg) ? tg.x : 0.f; baseb += (g < rg) ? tg.y : 0.f; }
        LAS unsigned char* kimg = lds + H1_K + (k >> 5) * BS1 + (k & 31) * 2 + (rg * 32) * 64;
        f32x2 base2 = {basea, baseb}; const f32x2 all2 = {alla, allb};
#define H1_ROW(LF, i, row) do { \
            const f32x2 l2 = {__builtin_bit_cast(float, LF[i] << 16), __builtin_bit_cast(float, LF[i] & 0xffff0000u)}; \
            const f32x2 kk = 1.f - (f32x2){__builtin_amdgcn_exp2f(l2.x), __builtin_amdgcn_exp2f(l2.y)}; \
            f32x2 w; \
            if (dir == 0) { base2 += l2; const f32x2 d_ = all2 - base2; w = (f32x2){__builtin_amdgcn_exp2f(d_.x), __builtin_amdgcn_exp2f(d_.y)}; } \
            else { w = (f32x2){__builtin_amdgcn_exp2f(base2.x), __builtin_amdgcn_exp2f(base2.y)}; base2 += l2; } \
            const f32x2 kw = kk * w; \
            *(LAS unsigned*)(kimg + (row) * 64) = cvt_pk_bf16(kw.x, kw.y); } while (0)
#pragma unroll
        for (int i = 0; i < 16; ++i) H1_ROW(R.lfa, i, i);
#pragma unroll
        for (int i = 0; i < 16; ++i) H1_ROW(R.lfb, i, 16 + i);
#undef H1_ROW
        if (rg == 0) *(f32x2*)(Dv + (size_t)unit * 128 + k) = (f32x2){__builtin_amdgcn_exp2f(alla), __builtin_amdgcn_exp2f(allb)};
        if (unit + stride < 512) h1_load(P, unit + stride, tid, R);
        HBAR();
        const int vb = wid & 3, kb0 = 2 * (wid >> 2);
        const int trb = ((lane >> 4) & 1) * 32 + (lane & 3) * 8 + (8 * hh + ((lane & 15) >> 2)) * 64;
        f32x16 u0 = {}, u1 = {};
#pragma unroll 4
        for (int ks = 0; ks < 16; ++ks) {
            LAS unsigned char* vp = lds + H1_V + vb * BS1 + trb + ks * 1024; const s16x4 vl = vtr(vp), vh = vtr(vp + 256);
            const bf16x8 vf = {vl[0], vl[1], vl[2], vl[3], vh[0], vh[1], vh[2], vh[3]};
            LAS unsigned char* ap = lds + H1_K + kb0 * BS1 + trb + ks * 1024; const s16x4 al = vtr(ap), ah = vtr(ap + 256), bl = vtr(ap + BS1), bh = vtr(ap + BS1 + 256);
            const bf16x8 a0 = {al[0], al[1], al[2], al[3], ah[0], ah[1], ah[2], ah[3]}, a1 = {bl[0], bl[1], bl[2], bl[3], bh[0], bh[1], bh[2], bh[3]};
            u0 = MFMA32(a0, vf, u0); u1 = MFMA32(a1, vf, u1);
        }
#pragma unroll
        for (int g4 = 0; g4 < 4; ++g4) { GAS float* up0 = launder_g(U + (size_t)unit * 16384 + vb * 32 + r32 + (size_t)(kb0 * 32 + 8 * g4 + 4 * hh) * 128);
#pragma unroll
            for (int i = 0; i < 4; ++i) { up0[i * 128] = u0[4 * g4 + i]; up0[(32 + i) * 128] = u1[4 * g4 + i]; } }
        HBAR();
    }
}

__device__ __forceinline__ void scan_phase(float* U, const float* Dv, int gtid) {
    const int seq = gtid >> 13, k = (gtid >> 6) & 127, v = (gtid & 63) * 2;
    if (seq >= 16) return;
    f32x2 S = {0.f, 0.f};
    float* up = U + (size_t)seq * 32 * 16384 + k * 128 + v; const float* dp = Dv + (size_t)seq * 32 * 128 + k;
    f32x2 uu[32]; float dd[32];
#pragma unroll
    for (int p = 0; p < 32; ++p) { uu[p] = *(const GAS f32x2*)(up + (size_t)p * 16384); dd[p] = *(const GAS float*)(dp + p * 128); }
#pragma unroll
    for (int p = 0; p < 32; ++p) { S = S * dd[p] + uu[p]; *(GAS f32x2*)(up + (size_t)p * 16384) = S; }
}

constexpr int BS3 = 4160, PST = 144;
constexpr int D_Q = 0, D_K = 4 * BS3, D_V = 8 * BS3, D_P = 12 * BS3, D_TOT = D_P + 64 * PST, D_VEC = D_TOT + 2048, D_NP = D_VEC + 1536, DSZ = 65536;
static_assert(D_NP + 1024 <= DSZ, "H3 LDS block");

__device__ __forceinline__ void h3_load(const bf16_t* Pc, bool bwd, int h, int t4, u32x16& lfw, u32x16& qw, u32x16& vr) {
    const int k = 2 * (t4 & 63), rg = t4 >> 6;
    const GAS char* bl = (const GAS char*)(Pc + COL_LF + (bwd ? 512 : 0) + h * 128);
    const GAS char* bq = (const GAS char*)(Pc + COL_Q + h * 128);
    unsigned off = (unsigned)((rg * 16) * NPJ + k) * 2u;
#pragma unroll
    for (int i = 0; i < 16; ++i) { lfw[i] = *(const GAS unsigned*)(bl + off); qw[i] = *(const GAS unsigned*)(bq + off); off += (unsigned)NPJ * 2u; asm volatile("" : "+v"(off)); }
    const GAS char* bv = (const GAS char*)(Pc + COL_V + h * 128);
    unsigned voff = (unsigned)((t4 >> 4) * NPJ + (t4 & 15) * 8) * 2u;
#pragma unroll
    for (int i = 0; i < 4; ++i) { const u32x4 t_ = *(const GAS u32x4*)(bv + voff); vr[4 * i] = t_.x; vr[4 * i + 1] = t_.y; vr[4 * i + 2] = t_.z; vr[4 * i + 3] = t_.w; voff += 16u * (unsigned)NPJ * 2u; asm volatile("" : "+v"(voff)); }
}

__device__ __forceinline__ void h3_step(LAS unsigned char* L, bool bwd, const bf16_t* Pn, bool nbwd, int h, int t4_, int vb, int lane_,
                                        u32x16& lfw, u32x16& qw, u32x16& vr, f32x16 (&o)[2], f32x16 (&S)[4]) {
    int t4 = t4_, lane = lane_; asm volatile("" : "+v"(t4), "+v"(lane));
    const int hh = lane >> 5, r32 = lane & 31;
#pragma unroll
    for (int i = 0; i < 4; ++i) { const int pc = t4 + 256 * i, s = pc >> 4, j = pc & 15; *(LAS u32x4*)(L + D_V + (j >> 2) * BS3 + s * 64 + (j & 3) * 16) = (u32x4){vr[4 * i], vr[4 * i + 1], vr[4 * i + 2], vr[4 * i + 3]}; }
    const int k = 2 * (t4 & 63), rg = t4 >> 6;
    float tota = 0.f, totb = 0.f;
#pragma unroll
    for (int i = 0; i < 16; ++i) { tota += __builtin_bit_cast(float, lfw[i] << 16); totb += __builtin_bit_cast(float, lfw[i] & 0xffff0000u); }
    LAS float* totl = (LAS float*)(L + D_TOT);
    *(LAS f32x2*)(totl + rg * 128 + k) = (f32x2){tota, totb};
    HBAR();
    float bca = 0.f, bcb = 0.f, alla = 0.f, allb = 0.f;
#pragma unroll
    for (int g = 0; g < 4; ++g) { const f32x2 tg = *(const LAS f32x2*)(totl + g * 128 + k);
        alla += tg.x; allb += tg.y;
        const bool before = bwd ? (g > rg) : (g < rg); bca += before ? tg.x : 0.f; bcb += before ? tg.y : 0.f; }
    LAS unsigned char* qimg = L + D_Q + (k >> 5) * BS3 + (k & 31) * 2 + (rg * 16) * 64;
    LAS unsigned char* kimg = L + D_K + (k >> 5) * BS3 + (k & 31) * 2 + (rg * 16) * 64;
    f32x2 bc = {bca - alla, bcb - allb};
#define H3_ROW(i) do { \
        const f32x2 l2 = {__builtin_bit_cast(float, lfw[i] << 16), __builtin_bit_cast(float, lfw[i] & 0xffff0000u)}; \
        const f32x2 qv = {__builtin_bit_cast(float, qw[i] << 16), __builtin_bit_cast(float, qw[i] & 0xffff0000u)}; \
        bc += l2; \
        const f32x2 e = {__builtin_amdgcn_exp2f(bc.x), __builtin_amdgcn_exp2f(bc.y)}; \
        const f32x2 kk = 1.f - (f32x2){__builtin_amdgcn_exp2f(l2.x), __builtin_amdgcn_exp2f(l2.y)}; \
        const f32x2 qe = qv * e, ke = kk * (f32x2){__builtin_amdgcn_rcpf(e.x), __builtin_amdgcn_rcpf(e.y)}; \
        *(LAS unsigned*)(qimg + (i) * 64) = cvt_pk_bf16(qe.x, qe.y); \
        *(LAS unsigned*)(kimg + (i) * 64) = cvt_pk_bf16(ke.x, ke.y); } while (0)
    if (bwd) {
#pragma unroll
        for (int ii = 0; ii < 16; ++ii) H3_ROW(15 - ii);
    } else {
#pragma unroll
        for (int ii = 0; ii < 16; ++ii) H3_ROW(ii);
    }
#undef H3_ROW
    LAS float* vec = (LAS float*)(L + D_VEC);
    if (rg == 0) *(LAS f32x2*)(vec + k) = (f32x2){__builtin_amdgcn_exp2f(alla), __builtin_amdgcn_exp2f(allb)};
    asm volatile("" ::: "memory");
    h3_load(Pn, nbwd, h, t4, lfw, qw, vr);
    HBAR();
#pragma unroll
    for (int kb = 0; kb < 4; ++kb)
#pragma unroll
        for (int g4 = 0; g4 < 4; ++g4) { const f32x4 d4 = *(const LAS f32x4*)(vec + kb * 32 + 8 * g4 + 4 * hh);
#pragma unroll
            for (int i = 0; i < 4; ++i) S[kb][4 * g4 + i] *= d4[i]; }
    {
        const int sb = vb & 1, rb = vb >> 1;
        f32x16 sc = {};
#pragma unroll
        for (int ks = 0; ks < 8; ++ks) { const int off = (ks >> 1) * BS3 + (ks & 1) * 32 + hh * 16;
            const bf16x8 a = *(const LAS bf16x8*)(L + D_K + off + (32 * sb + r32) * 64), bq = *(const LAS bf16x8*)(L + D_Q + off + (32 * rb + r32) * 64);
            sc = MFMA32(a, bq, sc); }
        const int rr = 32 * rb + r32;
        const int d0 = bwd ? (rr - 32 * sb - 4 * hh) : (32 * sb + 4 * hh - rr);
#pragma unroll
        for (int g = 0; g < 4; ++g) { const int s0 = 32 * sb + 8 * g + 4 * hh; float pv[4];
#pragma unroll
            for (int i = 0; i < 4; ++i) { const int cgi = 8 * g + i; const bool keep = d0 <= (bwd ? cgi : -cgi); pv[i] = keep ? sc[4 * g + i] : 0.f; }
            u32x2 w; w.x = cvt_pk_bf16(pv[0], pv[1]); w.y = cvt_pk_bf16(pv[2], pv[3]);
            *(LAS u32x2*)(L + D_P + rr * PST + s0 * 2) = w; }
    }
#pragma unroll
    for (int kb = 0; kb < 4; ++kb)
#pragma unroll
        for (int s = 0; s < 2; ++s) {
            u32x4 bw; bw.x = cvt_pk_bf16(S[kb][8 * s], S[kb][8 * s + 1]); bw.y = cvt_pk_bf16(S[kb][8 * s + 2], S[kb][8 * s + 3]); bw.z = cvt_pk_bf16(S[kb][8 * s + 4], S[kb][8 * s + 5]); bw.w = cvt_pk_bf16(S[kb][8 * s + 6], S[kb][8 * s + 7]);
            const bf16x8 bf = __builtin_bit_cast(bf16x8, bw);
#pragma unroll
            for (int rb = 0; rb < 2; ++rb) {
                LAS unsigned char* ap = L + D_Q + kb * BS3 + (32 * rb + r32) * 64 + (16 * s + 4 * hh) * 2;
                const u32x2 a0 = *(const LAS u32x2*)ap, a1 = *(const LAS u32x2*)(ap + 16);
                const u32x4 aw = {a0.x, a0.y, a1.x, a1.y};
                o[rb] = MFMA32(__builtin_bit_cast(bf16x8, aw), bf, o[rb]); }
        }
    HBAR();
    const int trb = ((lane >> 4) & 1) * 32 + (lane & 3) * 8 + (8 * hh + ((lane & 15) >> 2)) * 64;
    bf16x8 vf[4];
#pragma unroll
    for (int ks = 0; ks < 4; ++ks) { LAS unsigned char* vp = L + D_V + vb * BS3 + trb + ks * 1024; const s16x4 vl = vtr(vp), vh = vtr(vp + 256);
        vf[ks] = (bf16x8){vl[0], vl[1], vl[2], vl[3], vh[0], vh[1], vh[2], vh[3]}; }
#pragma unroll
    for (int rb = 0; rb < 2; ++rb)
#pragma unroll
        for (int ks = 0; ks < 4; ++ks) { const bf16x8 pa = *(const LAS bf16x8*)(L + D_P + (32 * rb + r32) * PST + ks * 32 + hh * 16); o[rb] = MFMA32(pa, vf[ks], o[rb]); }
#pragma unroll
    for (int kb = 0; kb < 4; ++kb)
#pragma unroll
        for (int ks = 0; ks < 4; ++ks) { LAS unsigned char* ap = L + D_K + kb * BS3 + trb + ks * 1024; const s16x4 al = vtr(ap), ah = vtr(ap + 256);
            const bf16x8 a0 = {al[0], al[1], al[2], al[3], ah[0], ah[1], ah[2], ah[3]}; S[kb] = MFMA32(a0, vf[ks], S[kb]); }
    HBAR();
}

__device__ __forceinline__ void h3_unit(LAS unsigned char* lds, const bf16_t* P, const float* U, bf16_t* mix, float* ofw  , const float* hg_norm, int unit) {
    const int tid = opaque_tid(), lane = tid & 63, hh = lane >> 5, r32 = lane & 31; const int wid = __builtin_amdgcn_readfirstlane(tid >> 6);
    const int dir = wid >> 2, vb = wid & 3, t4 = tid & 255;
    const bool bwd = dir != 0;
    const int sc = 1 + (unit & 31), h = (unit >> 5) & 3, b = unit >> 7;
    const bf16_t* Pr = P + (size_t)(b * RB + sc * 256) * NPJ;
    LAS unsigned char* L = lds + dir * DSZ;
    float* of = ofw + (size_t)unit * 32768 + vb * 32 + r32;
    f32x16 S[4];
    { const float* Us = U + ((size_t)(((b * 4 + h) * 2 + dir) * 32 + (bwd ? 32 - sc : sc - 1))) * 16384 + vb * 32 + r32;
#pragma unroll
      for (int kb = 0; kb < 4; ++kb)
#pragma unroll
        for (int g4 = 0; g4 < 4; ++g4) { const GAS float* up = launder_g(Us + (size_t)(kb * 32 + 8 * g4 + 4 * hh) * 128);
#pragma unroll
            for (int i = 0; i < 4; ++i) S[kb][4 * g4 + i] = up[i * 128]; } }
    u32x16 lfw, qw, vr;
    h3_load(Pr + (size_t)(bwd ? 192 : 0) * NPJ, bwd, h, t4, lfw, qw, vr);
    const float gn = hg_norm[vb * 32 + r32];
    const int t0 = (sc - 1) * 256;
    LAS float* np = (LAS float*)(L + D_NP);
#pragma unroll 1
    for (int st = 0; st < 4; ++st) {
        const int c = bwd ? 3 - st : st, cn = st < 3 ? (bwd ? c - 1 : c + 1) : c;
        f32x16 o[2];
        if (st < 2) { o[0] = f32x16{}; o[1] = f32x16{}; }
        else {
#pragma unroll
            for (int rb = 0; rb < 2; ++rb)
#pragma unroll
                for (int g4 = 0; g4 < 4; ++g4) { const GAS float* op = launder_g(of + (size_t)(64 * c + 4 * hh + 32 * rb + 8 * g4) * 128);
#pragma unroll
                    for (int i = 0; i < 4; ++i) o[rb][4 * g4 + i] = op[i * 128]; }
        }
        h3_step(L, bwd, Pr + (size_t)(64 * cn) * NPJ, bwd, h, t4, vb, lane, lfw, qw, vr, o, S);
        if (st < 2) {
#pragma unroll
            for (int rb = 0; rb < 2; ++rb)
#pragma unroll
                for (int g4 = 0; g4 < 4; ++g4) { GAS float* op = launder_g(of + (size_t)(64 * c + 4 * hh + 32 * rb + 8 * g4) * 128);
#pragma unroll
                    for (int i = 0; i < 4; ++i) op[i * 128] = o[rb][4 * g4 + i]; asm volatile("" ::: "memory"); }
            if (st == 1) { VM_WAIT(); HBAR(); }
        } else {
            unsigned short gv[2][16];
            { const GAS char* bg = (const GAS char*)(Pr + COL_G + h * 128 + vb * 32);
              unsigned goff = (unsigned)((64 * c + 4 * hh) * NPJ + r32) * 2u;
#pragma unroll
              for (int rb = 0; rb < 2; ++rb)
#pragma unroll
                for (int g4 = 0; g4 < 4; ++g4)
#pragma unroll
                    for (int i = 0; i < 4; ++i) { gv[rb][4 * g4 + i] = *(const GAS unsigned short*)(bg + goff); goff += (unsigned)((i < 3 ? 1 : 5) * NPJ * 2); asm volatile("" : "+v"(goff)); } }
#pragma unroll
            for (int rb = 0; rb < 2; ++rb)
#pragma unroll
                for (int r8 = 0; r8 < 16; r8 += 8) { float ssv[8];
#pragma unroll
                    for (int r = 0; r < 8; ++r) ssv[r] = half_sum32(o[rb][r8 + r] * o[rb][r8 + r]);
                    if (r32 == 0) {
#pragma unroll
                        for (int r = 0; r < 8; ++r) np[(32 * rb + crow(r8 + r, hh)) * 4 + vb] = ssv[r]; } }
            HBAR();
#pragma unroll
            for (int rb = 0; rb < 2; ++rb)
#pragma unroll
                for (int g4 = 0; g4 < 4; ++g4) {
                    GAS bf16_t* mp = launder_g(mix + (size_t)(b * SEQ + t0 + 64 * c + 4 * hh + 32 * rb + 8 * g4) * DM + 512 + h * 128 + vb * 32 + r32);
#pragma unroll
                    for (int i = 0; i < 4; ++i) { const int r = 4 * g4 + i; const f32x4 q4 = *(const LAS f32x4*)(np + (4 * hh + 32 * rb + 8 * g4 + i) * 4);
                        const float rstd = __builtin_amdgcn_rsqf(((q4.x + q4.y) + (q4.z + q4.w)) * (1.f / 128.f) + NORM_EPS);
                        const float ov = o[rb][r] * rstd * gn * bf2f(gv[rb][r]); mp[(size_t)i * DM] = (bf16_t)cvt_pk_bf16(ov, ov); } }
        }
    }
    __syncthreads();
}
}


namespace att2 {
using att::crow; using att::vtr;
constexpr int KSTR = 1040, KCOMP = 8 * KSTR, KBUF = 2 * KCOMP, VDB = 4160, VBUF = 4 * VDB;
constexpr int LDS_K = 0, LDS_V = 4 * KBUF, LDS_WS = LDS_V + 3 * VBUF;
constexpr int NT = RB / 64;
#define SBAR() __builtin_amdgcn_sched_barrier(0)
#define PIN(x) asm volatile("" : "+v"(x))
#define WAIT_BAR(N) asm volatile("s_waitcnt vmcnt(" #N ") lgkmcnt(0)\n\ts_barrier" ::: "memory")
__device__ __forceinline__ void glds16(const void* g, unsigned lds_base) {
    unsigned sv; asm volatile("s_mov_b32 %0, m0\n\ts_mov_b32 m0, %2\n\ts_nop 0\n\tglobal_load_lds_dwordx4 %1, off\n\ts_mov_b32 m0, %0" : "=&s"(sv) : "v"(g), "s"(lds_base) : "memory"); }
__device__ __forceinline__ unsigned cvtpk_s(float lo, float hi) { typedef __bf16 bf16x2_t __attribute__((ext_vector_type(2))); f32x2 v = {lo, hi}; bf16x2_t b = __builtin_convertvector(v, bf16x2_t); return __builtin_bit_cast(unsigned, b); }

__device__ __forceinline__ void attn_unit(LAS unsigned char* lds, const bf16_t* P, const bf16_t* KI, const bf16_t* VI, bf16_t* mix, int b, int h, int qb, float lam, const float* subln) {
    const int tid = opaque_tid(), lane = tid & 63, r32 = lane & 31, hh = lane >> 5; const int wid = __builtin_amdgcn_readfirstlane(tid >> 6);
    const int comp = wid >> 2, rbk = wid & 3;
    const bf16_t* Pb = P + (size_t)b * RB * NPJ;
    const unsigned lds0 = (unsigned)(size_t)lds;
    const bf16_t* ksrc = KI + (size_t)((b * 4 + h) * 132) * 8192 + wid * 512 + lane * 8;
    const bf16_t* vsrc = VI + (size_t)((b * 4 + h) * 132) * 8192 + wid * 1024 + lane * 8;
    const unsigned kdst = lds0 + LDS_K + wid * KSTR, vdst = lds0 + LDS_V + (wid >> 1) * VDB + (wid & 1) * 2048;
#define DMA_K0(t, slot) glds16(ksrc + (size_t)(t) * 8192, (unsigned)__builtin_amdgcn_readfirstlane(kdst + (slot)))
#define DMA_K1(t, slot) glds16(ksrc + (size_t)(t) * 8192 + 4096, (unsigned)__builtin_amdgcn_readfirstlane(kdst + KCOMP + (slot)))
#define DMA_V0(t, slot) glds16(vsrc + (size_t)(t) * 8192, (unsigned)__builtin_amdgcn_readfirstlane(vdst + (slot)))
#define DMA_V1(t, slot) glds16(vsrc + (size_t)(t) * 8192 + 512, (unsigned)__builtin_amdgcn_readfirstlane(vdst + 1024 + (slot)))
    DMA_K0(0, 0); DMA_K1(0, 0); DMA_V0(0, 0); DMA_V1(0, 0); DMA_K0(1, KBUF); DMA_K1(1, KBUF); DMA_K0(2, 2 * KBUF); DMA_K1(2, 2 * KBUF);
    const int qrow = CTXL + qb * 128 + rbk * 32 + r32;
    const bf16_t* qp = Pb + (size_t)qrow * NPJ + h * 128 + comp * 64 + hh * 8;
    bf16x8 qf[4];
#pragma unroll
    for (int ks = 0; ks < 4; ++ks) qf[ks] = *(const bf16x8*)(qp + ks * 16);
    LAS unsigned char* kp0 = lds + LDS_K + comp * KCOMP + hh * KSTR + r32 * 16;
    LAS unsigned char* vp0 = lds + LDS_V + ((lane >> 4) & 1) * 32 + (lane & 3) * 8 + (4 * hh + ((lane & 15) >> 2)) * 64;
    int kpv = 3 * KBUF, kc = 0, kn = KBUF, kn2 = 2 * KBUF;
    int vp = 2 * VBUF, vc = 0, vn = VBUF;
#define ROT() do { const int a_ = kpv; kpv = kc; kc = kn; kn = kn2; kn2 = a_; const int b_ = vp; vp = vc; vc = vn; vn = b_; } while (0)
#define LDK(i) (*(const LAS bf16x8*)(kq + ((i) >> 1) * 2 * KSTR + ((i) & 1) * 512))
    f32x16 o[4]; o[0] = f32x16{}; o[1] = f32x16{}; o[2] = f32x16{}; o[3] = f32x16{};
    f32x16 negm, pA0, pA1, pB0, pB1;
    float lsum = 0.f;
    WAIT_BAR(6);
    {
        LAS unsigned char* kq = kp0 + kc;
        f32x16 s0 = {}, s1 = {};
#pragma unroll
        for (int i = 0; i < 8; i += 2) { s0 = MFMA32(LDK(i), qf[i >> 1], s0); s1 = MFMA32(LDK(i + 1), qf[i >> 1], s1); }
        float m = fmaxf(s0[0], s1[0]);
#pragma unroll
        for (int r = 1; r < 16; ++r) m = fmaxf(m, fmaxf(s0[r], s1[r]));
        m = fmaxf(m, __shfl_xor(m, 32));
#pragma unroll
        for (int r = 0; r < 16; ++r) { negm[r] = -m; pA0[r] = __builtin_amdgcn_exp2f(s0[r] - m); pA1[r] = __builtin_amdgcn_exp2f(s1[r] - m); }
        asm volatile("" : "+v"(negm));
        DMA_K0(3, kpv); DMA_K1(3, kpv); DMA_V0(1, vn); DMA_V1(1, vn);
        WAIT_BAR(4);
        ROT();
    }
    bf16x8 kfa, kfb;
    { LAS unsigned char* kq = kp0 + kc; kfa = LDK(0); kfb = LDK(1); }
    u32x4 pw0, pw1, pw2, pw3;
#define PKW(Pv, B) cvtpk_s(Pv[B], Pv[(B) + 1])
#define VLD(j) do { LAS unsigned char* a_ = vq + ((j) & 3) * VDB + ((j) >> 2) * 1024; vlo[j] = vtr(a_); vhi[j] = vtr(a_ + 512); } while (0)
#define VFR(j) (bf16x8){vlo[j][0], vlo[j][1], vlo[j][2], vlo[j][3], vhi[j][0], vhi[j][1], vhi[j][2], vhi[j][3]}
#define GAPA(i, Cx, CIN, A0, A1, A2, A3, W0, W1, PW) do { if ((i) + 2 < 8) kf[(i) + 2] = LDK((i) + 2); if ((i) >= 6) VLD((i) - 6); \
        Cx = MFMA32(kf[i], qf[(i) >> 1], CIN); sacc += A0; sacc += A1; sacc += A2; sacc += A3; PIN(sacc); W0; W1; PIN(PW); SBAR(); } while (0)
#define GAPB(j, PWv, X, B, EXTRA) do { if ((j) + 2 < 16) VLD((j) + 2); EXTRA; o[(j) & 3] = MFMA32(__builtin_bit_cast(bf16x8, PWv), VFR(j), o[(j) & 3]); \
        X[B] = __builtin_amdgcn_exp2f(X[B]); X[(B) + 1] = __builtin_amdgcn_exp2f(X[(B) + 1]); PIN(X); SBAR(); } while (0)
#define STEP(C0, C1, P0, P1, t, GK, GV, PRE) do { SBAR(); \
        LAS unsigned char* kq = kp0 + kc; LAS unsigned char* vq = vp0 + vp; LAS unsigned char* kqn = kp0 + kn; \
        bf16x8 kf[8]; s16x4 vlo[16], vhi[16]; \
        kf[0] = kfa; kf[1] = kfb; \
        float sacc = P0[0] + P0[1]; \
        GAPA(0, C0, negm, P0[2], P0[3], P0[4], P0[5],     pw0[0] = PKW(P0, 0),  pw0[1] = PKW(P0, 2),  pw0); \
        GAPA(1, C1, negm, P0[6], P0[7], P0[8], P0[9],     pw0[2] = PKW(P0, 4),  pw0[3] = PKW(P0, 6),  pw0); \
        GAPA(2, C0, C0,   P0[10], P0[11], P0[12], P0[13], pw1[0] = PKW(P0, 8),  pw1[1] = PKW(P0, 10), pw1); \
        GAPA(3, C1, C1,   P0[14], P0[15], P1[0], P1[1],   pw1[2] = PKW(P0, 12), pw1[3] = PKW(P0, 14), pw1); \
        GAPA(4, C0, C0,   P1[2], P1[3], P1[4], P1[5],     pw2[0] = PKW(P1, 0),  pw2[1] = PKW(P1, 2),  pw2); \
        GAPA(5, C1, C1,   P1[6], P1[7], P1[8], P1[9],     pw2[2] = PKW(P1, 4),  pw2[3] = PKW(P1, 6),  pw2); \
        GAPA(6, C0, C0,   P1[10], P1[11], P1[12], P1[13], pw3[0] = PKW(P1, 8),  pw3[1] = PKW(P1, 10), pw3); \
        GAPA(7, C1, C1,   P1[14], P1[15], 0.f, 0.f,       pw3[2] = PKW(P1, 12), pw3[3] = PKW(P1, 14), pw3); \
        lsum += sacc; \
        GAPB(0, pw0, C0, 0, if (GK) DMA_K0((t) + 3, kpv));  GAPB(1, pw0, C0, 2, if (GK) DMA_K1((t) + 3, kpv));  GAPB(2, pw0, C0, 4, if (GV) DMA_V0((t) + 1, vn));  GAPB(3, pw0, C0, 6, if (GV) DMA_V1((t) + 1, vn)); \
        GAPB(4, pw1, C0, 8, (void)0);  GAPB(5, pw1, C0, 10, (void)0); GAPB(6, pw1, C0, 12, (void)0); GAPB(7, pw1, C0, 14, (void)0); \
        GAPB(8, pw2, C1, 0, (void)0);  GAPB(9, pw2, C1, 2, (void)0);  GAPB(10, pw2, C1, 4, (void)0); GAPB(11, pw2, C1, 6, (void)0); \
        GAPB(12, pw3, C1, 8, (void)0); GAPB(13, pw3, C1, 10, (void)0); GAPB(14, pw3, C1, 12, if (PRE) kfa = *(const LAS bf16x8*)(kqn)); GAPB(15, pw3, C1, 14, if (PRE) kfb = *(const LAS bf16x8*)(kqn + 512)); \
    } while (0)
#pragma unroll 1
    for (int t = 1; t + 1 <= NT - 4; t += 2) {
        STEP(pB0, pB1, pA0, pA1, t, true, true, true);     WAIT_BAR(4); ROT();
        STEP(pA0, pA1, pB0, pB1, t + 1, true, true, true); WAIT_BAR(4); ROT();
    }
    STEP(pB0, pB1, pA0, pA1, NT - 3, false, true, true);   WAIT_BAR(2); ROT();
    STEP(pA0, pA1, pB0, pB1, NT - 2, false, true, true);   WAIT_BAR(2); ROT();
    STEP(pB0, pB1, pA0, pA1, NT - 1, false, false, false); WAIT_BAR(0); ROT();
    {
        float sacc = 0.f;
#pragma unroll
        for (int r = 0; r < 16; ++r) sacc += pB0[r] + pB1[r];
        lsum += sacc;
        pw0 = (u32x4){PKW(pB0, 0), PKW(pB0, 2), PKW(pB0, 4), PKW(pB0, 6)}; pw1 = (u32x4){PKW(pB0, 8), PKW(pB0, 10), PKW(pB0, 12), PKW(pB0, 14)};
        pw2 = (u32x4){PKW(pB1, 0), PKW(pB1, 2), PKW(pB1, 4), PKW(pB1, 6)}; pw3 = (u32x4){PKW(pB1, 8), PKW(pB1, 10), PKW(pB1, 12), PKW(pB1, 14)};
        LAS unsigned char* vq = vp0 + vp;
#pragma unroll
        for (int j = 0; j < 16; ++j) { LAS unsigned char* a_ = vq + (j & 3) * VDB + (j >> 2) * 1024; const s16x4 lo = vtr(a_), hi = vtr(a_ + 512);
            const bf16x8 vf = {lo[0], lo[1], lo[2], lo[3], hi[0], hi[1], hi[2], hi[3]};
            const u32x4 pws = (j >> 2) == 0 ? pw0 : (j >> 2) == 1 ? pw1 : (j >> 2) == 2 ? pw2 : pw3;
            o[j & 3] = MFMA32(__builtin_bit_cast(bf16x8, pws), vf, o[j & 3]); }
    }
    __syncthreads();
    lsum += __shfl_xor(lsum, 32);
    LAS float* wsf = (LAS float*)(lds + LDS_WS) + wid * 64;
    if (hh == 0) wsf[r32] = lsum;
    LDS_WAIT();
    LAS float* X = (LAS float*)lds + rbk * 4096;
    const float cmul = comp ? lam : 1.f;
#pragma unroll
    for (int r = 0; r < 16; ++r) { const float sc = cmul * __builtin_amdgcn_rcpf(wsf[crow(r, hh)]);
#pragma unroll
        for (int db = 0; db < 4; ++db) o[db][r] *= sc; }
    if (comp == 1) {
#pragma unroll
        for (int db = 0; db < 4; ++db)
#pragma unroll
            for (int r = 0; r < 16; ++r) X[(db * 16 + r) * 64 + lane] = o[db][r];
    }
    __syncthreads();
    if (comp == 0) {
        float sl[4];
#pragma unroll
        for (int db = 0; db < 4; ++db) sl[db] = subln[db * 32 + r32] * (1.f - LAMBDA_INIT);
        bf16_t* orow = mix + (size_t)(b * SEQ + qb * 128 + rbk * 32 + 4 * hh) * DM + h * 128 + r32;
#pragma unroll
        for (int r = 0; r < 16; ++r) {
            float ss = 0.f;
#pragma unroll
            for (int db = 0; db < 4; ++db) { o[db][r] -= X[(db * 16 + r) * 64 + lane]; ss += o[db][r] * o[db][r]; }
            ss = half_sum32(ss);
            const float rstd = __builtin_amdgcn_rsqf(ss * (1.f / 128.f) + NORM_EPS);
#pragma unroll
            for (int db = 0; db < 4; ++db) orow[(size_t)((r & 3) + 8 * (r >> 2)) * DM + db * 32] = (bf16_t)f2bf(o[db][r] * rstd * sl[db]);
        }
    }
    __syncthreads();
#undef DMA_K0
#undef DMA_K1
#undef DMA_V0
#undef DMA_V1
#undef ROT
#undef LDK
#undef PKW
#undef VLD
#undef VFR
#undef GAPA
#undef GAPB
#undef STEP
}
#undef SBAR
#undef PIN
#undef WAIT_BAR
}

struct SchedPlain {
    int nM, nN, nwg, G, c; const bf16_t* Bt; int K;
    __device__ bool next(int i, pg8::Unit& u) const {
        const long L = (long)i * G + c; if (L >= nwg) return false;
        int wgid = (int)L; { const int q = nwg / 8, r = nwg % 8, xcd = wgid % 8, off = wgid / 8; wgid = (xcd < r ? xcd * (q + 1) : r * (q + 1) + (xcd - r) * q) + off; }
        const int nig = 8 * nN, gid = wgid / nig, fm = gid * 8, gsz = (nM - fm) < 8 ? (nM - fm) : 8;
        u.pm = fm + ((wgid % nig) % gsz); u.pn = (wgid % nig) / gsz; u.arow0 = u.pm * 256; u.gadd = 0; u.gidx = nullptr; u.Bt = Bt + (size_t)u.pn * 256 * K; u.aux = 0; return true;
    }
};
struct EpiYbf16 {
    static constexpr bool PERM = true;
    bf16_t* O; int ldc;
    __device__ __forceinline__ void operator()(const f32x4 (&acc)[2][2][4][2], const pg8::Unit& u, int wr, int wc, int fr, int fq) const {
#pragma unroll
        for (int ai = 0; ai < 2; ++ai)
#pragma unroll
            for (int m = 0; m < 4; ++m) { bf16_t* rowp = O + (size_t)(u.pm * 256 + ai * 128 + wr * 64 + m * 16 + fr) * ldc + u.pn * 256 + wc * 32 + 8 * fq;
#pragma unroll
                for (int bj = 0; bj < 2; ++bj) { const f32x4 v0 = acc[ai][bj][m][0], v1 = acc[ai][bj][m][1];
                    u32x4 w; w.x = cvt_pk_bf16(v0[0], v0[1]); w.y = cvt_pk_bf16(v0[2], v0[3]); w.z = cvt_pk_bf16(v1[0], v1[1]); w.w = cvt_pk_bf16(v1[2], v1[3]);
                    *(u32x4*)(rowp + bj * 128) = w; } }
    }
};

__device__ __forceinline__ void p7_pre(Frame& F, const Args& a) {
    const int tid_ = opaque_tid();
    LAS float* par = (LAS float*)F.lds;
    LAS float* wrT = (LAS float*)(F.lds + 24576);
    const float* mod = (const float*)(a.ws + WS_MOD);
    for (int i = tid_; i < 2048; i += 512) { const int b = i >> 10, c = i & 1023;
        par[b * 3072 + c] = mod[b * 6144 + 2048 + c] * a.n_post_mix[c]; par[b * 3072 + 1024 + c] = a.n_pre_ffn[c] * (1.f + mod[b * 6144 + 4096 + c]); par[b * 3072 + 2048 + c] = mod[b * 6144 + 3072 + c]; }
    for (int i = tid_; i < 16384; i += 512) { const int c = i >> 4, e = i & 15; wrT[e * 1024 + c] = a.w_router[i]; }
}
__device__ __forceinline__ void p7_rowpass(Frame& F, const Args& a) {
    const int tid_ = opaque_tid(), lane_ = tid_ & 63; const int wave_ = __builtin_amdgcn_readfirstlane(tid_ >> 6);
    LAS float* par = (LAS float*)F.lds; LAS float* wrT = (LAS float*)(F.lds + 24576);
    __syncthreads();
    const bf16_t* ylat = (const bf16_t*)(a.ws + WS_YLAT); unsigned char* h2 = a.ws + WS_H2; float* aff = (float*)(a.ws + WS_AFF);
    const int gw = F.vcu * NWAVES + wave_, NGW = F.G * NWAVES;
    u32x2 ywn[2][4]; f32x4 xvn[2][4];
#define P7_LOAD(m0_) do { const bool v1_ = (m0_) + NGW < ML; const int mm_[2] = {(m0_), v1_ ? (m0_) + NGW : (m0_)}; \
        _Pragma("unroll") for (int u = 0; u < 2; ++u) { const GAS u32x2* yr = (const GAS u32x2*)(ylat + (size_t)mm_[u] * DM) + lane_; const GAS f32x4* xr = (const GAS f32x4*)(a.x + (size_t)mm_[u] * DM) + lane_; \
            _Pragma("unroll") for (int j = 0; j < 4; ++j) { ywn[u][j] = yr[64 * j]; xvn[u][j] = xr[64 * j]; } } } while (0)
    if (gw < ML) P7_LOAD(gw);
    for (int m0 = gw; m0 < ML; m0 += 2 * NGW) {
        const bool v1 = m0 + NGW < ML; const int mm[2] = {m0, v1 ? m0 + NGW : m0};
        f32x4 yv[2][4], xv[2][4]; float ss[2] = {0.f, 0.f};
#pragma unroll
        for (int u = 0; u < 2; ++u)
#pragma unroll
            for (int j = 0; j < 4; ++j) { const u32x2 w = ywn[u][j]; yv[u][j] = (f32x4){__builtin_bit_cast(float, w.x << 16), __builtin_bit_cast(float, w.x & 0xffff0000u), __builtin_bit_cast(float, w.y << 16), __builtin_bit_cast(float, w.y & 0xffff0000u)}; xv[u][j] = xvn[u][j]; }
        if (m0 + 2 * NGW < ML) P7_LOAD(m0 + 2 * NGW);
#pragma unroll
        for (int u = 0; u < 2; ++u)
#pragma unroll
            for (int j = 0; j < 4; ++j) ss[u] += (yv[u][j].x * yv[u][j].x + yv[u][j].y * yv[u][j].y) + (yv[u][j].z * yv[u][j].z + yv[u][j].w * yv[u][j].w);
        ss[0] = wave_sum(ss[0]); ss[1] = wave_sum(ss[1]);
        float ss2[2] = {0.f, 0.f};
#pragma unroll
        for (int u = 0; u < 2; ++u) { const int b = mm[u] >> 13; const float rstd = __builtin_amdgcn_rsqf(ss[u] * (1.f / DM) + NORM_EPS);
            GAS unsigned long long* orow = (GAS unsigned long long*)((bf16_t*)(a.ws + WS_X1B) + (size_t)mm[u] * DM) + lane_;
#pragma unroll
            for (int j = 0; j < 4; ++j) { const int c = 4 * lane_ + 256 * j; const f32x4 a1 = *(const LAS f32x4*)(par + b * 3072 + c);
                xv[u][j] = xv[u][j] + a1 * (yv[u][j] * rstd); if (u == 0 || v1) orow[64 * j] = (unsigned long long)cvt_pk_bf16(xv[u][j].x, xv[u][j].y) | ((unsigned long long)cvt_pk_bf16(xv[u][j].z, xv[u][j].w) << 32);
                ss2[u] += (xv[u][j].x * xv[u][j].x + xv[u][j].y * xv[u][j].y) + (xv[u][j].z * xv[u][j].z + xv[u][j].w * xv[u][j].w); } }
        ss2[0] = wave_sum(ss2[0]); ss2[1] = wave_sum(ss2[1]);
#pragma unroll
        for (int u = 0; u < 2; ++u) { if (u == 1 && !v1) break;
            const int m = mm[u], b = m >> 13, t = m & 8191;
            const float rstd2 = __builtin_amdgcn_rsqf(ss2[u] * (1.f / DM) + NORM_EPS);
            GAS unsigned* o8 = (GAS unsigned*)(h2 + (size_t)m * DM) + lane_;
            f32x2 lg2[16];
#pragma unroll
            for (int e = 0; e < 16; ++e) lg2[e] = (f32x2){0.f, 0.f};
#pragma unroll
            for (int j = 0; j < 4; ++j) { const int c = 4 * lane_ + 256 * j; const f32x4 a2 = *(const LAS f32x4*)(par + b * 3072 + 1024 + c), a3 = *(const LAS f32x4*)(par + b * 3072 + 2048 + c);
                const f32x4 hv = xv[u][j] * rstd2 * a2 + a3;
                { float h0 = hv.x, h1 = hv.y, h2_ = hv.z, h3 = hv.w; asm volatile("" : "+v"(h0), "+v"(h1), "+v"(h2_), "+v"(h3)); o8[64 * j] = cvt4_fp8_sat(h0, h1, h2_, h3); }
                const f32x2 hlo = {hv.x, hv.y}, hhi = {hv.z, hv.w};
#pragma unroll
                for (int e = 0; e < 16; ++e) { const f32x4 w = *(const LAS f32x4*)(wrT + e * 1024 + c); lg2[e] = __builtin_elementwise_fma(hlo, (f32x2){w.x, w.y}, lg2[e]); lg2[e] = __builtin_elementwise_fma(hhi, (f32x2){w.z, w.w}, lg2[e]); } }
            float lg[16];
#pragma unroll
            for (int e = 0; e < 16; ++e) lg[e] = lg2[e].x + lg2[e].y;
            const float lgt = reduce16(lg, lane_);
            const float mx = row_max16(lgt), pe = __expf(lgt - mx), den = row_sum16(pe);
            if (lane_ < 16) aff[(size_t)(b * 16 + lane_) * SEQ + t] = pe / den;
            __builtin_amdgcn_sched_barrier(0); }
    }
#undef P7_LOAD
    __syncthreads();
}


__device__ __forceinline__ void topk_unit(LAS unsigned char* lds, const float* aff, int* sel_idx, float* sel_gate, short* slot_map, int be) {
    const int tid = opaque_tid(), lane = tid & 63; const int wid = __builtin_amdgcn_readfirstlane(tid >> 6);
    const int b = be >> 4, e = be & 15;
    LAS unsigned* ctl = (LAS unsigned*)(lds + 1024);
    const float* ap = aff + (size_t)be * SEQ + tid * 16;
    unsigned key[16];
#pragma unroll
    for (int j = 0; j < 4; ++j) { const u32x4 v = *(const u32x4*)(ap + 4 * j); key[4 * j] = v.x; key[4 * j + 1] = v.y; key[4 * j + 2] = v.z; key[4 * j + 3] = v.w; }
    unsigned prefix = 0u;
#pragma unroll 1
    for (int bit = 30; bit >= 0; --bit) {
        const unsigned cand = prefix | (1u << bit);
        unsigned c = 0u;
#pragma unroll
        for (int i = 0; i < 16; ++i) c += key[i] >= cand ? 1u : 0u;
        c = wave_sum_u(c);
        LAS unsigned* bank = ctl + (bit & 1) * 8;
        if (lane == 0) bank[wid] = c;
        __syncthreads();
        unsigned tot = 0u;
#pragma unroll
        for (int w = 0; w < 8; ++w) tot += bank[w];
        if (tot >= (unsigned)CAP) prefix = cand;
    }
    unsigned need;
    {
        unsigned c = 0u;
#pragma unroll
        for (int i = 0; i < 16; ++i) c += key[i] > prefix ? 1u : 0u;
        c = wave_sum_u(c);
        __syncthreads();
        if (lane == 0) ctl[wid] = c;
        __syncthreads();
        unsigned tot = 0u;
#pragma unroll
        for (int w = 0; w < 8; ++w) tot += ctl[w];
        need = (unsigned)CAP - tot;
        __syncthreads();
    }
    const unsigned T = prefix;
    unsigned cg = 0u, ce = 0u;
#pragma unroll
    for (int i = 0; i < 16; ++i) { cg += key[i] > T ? 1u : 0u; ce += key[i] == T ? 1u : 0u; }
    unsigned pk = cg | (ce << 16), inc = pk;
#pragma unroll
    for (int o = 1; o < 64; o <<= 1) { const unsigned n = __shfl_up(inc, o); if (lane >= o) inc += n; }
    if (lane == 63) ctl[16 + wid] = inc;
    __syncthreads();
    unsigned wbase = 0u;
#pragma unroll
    for (int w = 0; w < 8; ++w) if (w < wid) wbase += ctl[16 + w];
    const unsigned excl = wbase + inc - pk;
    unsigned sg = excl & 0xffffu, se = excl >> 16;
    const unsigned total_gt = CAP - need;
    int* si = sel_idx + (size_t)be * CAP; float* sgp = sel_gate + (size_t)be * CAP; short* sm = slot_map + ((size_t)b * SEQ + tid * 16) * 16 + e;
#pragma unroll
    for (int i = 0; i < 16; ++i) {
        int slot = -1;
        if (key[i] > T) { slot = (int)sg; ++sg; }
        else if (key[i] == T) { if (se < need) slot = (int)(total_gt + se); ++se; }
        if (slot >= 0) { si[slot] = tid * 16 + i; sgp[slot] = __builtin_bit_cast(float, key[i]); }
        sm[i * 16] = (short)slot;
    }
    __syncthreads();
}

struct SchedMoe1 {
    int c; const bf16_t* Wgu; const int* sel_idx;
    __device__ bool next(int i, pg8::Unit& u) const {
        if (i >= 4) return false;
        const int x = c & 7, j = c >> 3, ui = i * 32 + j, e = x + 8 * (ui >> 6), rem = ui & 63, b = rem >> 5, mt = (rem >> 3) & 3, pn = rem & 7;
        u.pm = (b * 16 + e) * 4 + mt; u.pn = pn; u.arow0 = 0; u.gadd = b * SEQ; u.gidx = sel_idx + (size_t)(b * 16 + e) * CAP + mt * 256;
        u.Bt = (const bf16_t*)((const unsigned char*)Wgu + (size_t)e * 2097152 + (size_t)pn * 256 * 1024); u.aux = 0; return true;
    }
};
struct EpiSwiglu {
    static constexpr bool PERM = true;
    unsigned char* H;
    __device__ __forceinline__ void operator()(const f32x4 (&acc)[2][2][4][2], const pg8::Unit& u, int wr, int wc, int fr, int fq) const {
#pragma unroll
        for (int ai = 0; ai < 2; ++ai)
#pragma unroll
            for (int m = 0; m < 4; ++m) { unsigned char* rowp = H + (size_t)(u.pm * 256 + ai * 128 + wr * 64 + m * 16 + fr) * FFD + u.pn * 128 + wc * 32 + 8 * fq;
                float hv[8];
#pragma unroll
                for (int n = 0; n < 2; ++n)
#pragma unroll
                    for (int i = 0; i < 4; ++i) { const float ag = acc[ai][0][m][n][i], au = acc[ai][1][m][n][i];
                        hv[4 * n + i] = (ag * au) * (__builtin_amdgcn_rcpf(1.f + __builtin_amdgcn_exp2f(ag * (-W8_INV * 1.4426950408889634f))) * (W8_INV * W8_INV)); }
                u32x2 w; w.x = cvt4_fp8_sat(hv[0], hv[1], hv[2], hv[3]); w.y = cvt4_fp8_sat(hv[4], hv[5], hv[6], hv[7]);
                *(u32x2*)rowp = w; }
    }
};
struct SchedMoe2 {
    int c; const bf16_t* Wd;
    __device__ bool next(int i, pg8::Unit& u) const {
        if (i >= 2) return false;
        const int x = c & 7, j = c >> 3, e = x + 8 * i, b = j >> 4, mt = (j >> 2) & 3, pn = j & 3;
        u.pm = (b * 16 + e) * 4 + mt; u.pn = pn; u.arow0 = u.pm * 256; u.gadd = 0; u.gidx = nullptr;
        u.Bt = (const bf16_t*)((const unsigned char*)Wd + (size_t)e * 1048576 + (size_t)pn * 256 * 1024); u.aux = 0; return true;
    }
};
struct EpiGateBf16 {
    static constexpr bool PERM = true;
    bf16_t* Y; const float* gate;
    __device__ __forceinline__ void operator()(const f32x4 (&acc)[2][2][4][2], const pg8::Unit& u, int wr, int wc, int fr, int fq) const {
#pragma unroll
        for (int ai = 0; ai < 2; ++ai)
#pragma unroll
            for (int m = 0; m < 4; ++m) { const int row = u.pm * 256 + ai * 128 + wr * 64 + m * 16 + fr; const float gt = gate[row];
                bf16_t* rowp = Y + (size_t)row * DM + u.pn * 256 + wc * 32 + 8 * fq;
#pragma unroll
                for (int bj = 0; bj < 2; ++bj) { const f32x4 v0 = acc[ai][bj][m][0] * (gt * W8_INV), v1 = acc[ai][bj][m][1] * (gt * W8_INV);
                    u32x4 w; w.x = cvt_pk_bf16(v0[0], v0[1]); w.y = cvt_pk_bf16(v0[2], v0[3]); w.z = cvt_pk_bf16(v1[0], v1[1]); w.w = cvt_pk_bf16(v1[2], v1[3]);
                    *(u32x4*)(rowp + bj * 128) = w; } }
    }
};

__device__ __forceinline__ void p11_pre(Frame& F, const Args& a) {
    const int tid = opaque_tid();
    LAS float* par = (LAS float*)F.lds;
    const float* mod = (const float*)(a.ws + WS_MOD);
    for (int i = tid; i < 2048; i += 512) { const int b = i >> 10, c = i & 1023; par[i] = mod[b * 6144 + 5120 + c] * a.n_post_ffn[c]; }
}
__device__ __forceinline__ void p11_combine(Frame& F, const Args& a) {
    const int tid = opaque_tid(), lane = tid & 63; const int wave = __builtin_amdgcn_readfirstlane(tid >> 6);
    LAS float* par = (LAS float*)F.lds;
    __syncthreads();
    const bf16_t* ye = (const bf16_t*)(a.ws + WS_YE); const short* slot_map = (const short*)(a.ws + WS_SLOT);
    const int gw = F.vcu * NWAVES + wave, NGW = F.G * NWAVES;
    for (int m0 = gw; m0 < ML; m0 += 2 * NGW) {
        const bool v1 = m0 + NGW < ML; const int mm[2] = {m0, v1 ? m0 + NGW : m0};
        f32x4 f[2][4]; f32x4 xo[2][4];
#pragma unroll
        for (int u = 0; u < 2; ++u) { const int m = mm[u], b = m >> 13;
            const u32x4 s0 = *(const u32x4*)(slot_map + (size_t)m * 16), s1 = *(const u32x4*)(slot_map + (size_t)m * 16 + 8);
            const unsigned sw[8] = {s0.x, s0.y, s0.z, s0.w, s1.x, s1.y, s1.z, s1.w};
            const GAS u32x2* xr = (const GAS u32x2*)((const bf16_t*)(a.ws + WS_X1B) + (size_t)m * DM) + lane;
#pragma unroll
            for (int j = 0; j < 4; ++j) { f[u][j] = f32x4{}; const u32x2 w = xr[64 * j]; xo[u][j] = (f32x4){__builtin_bit_cast(float, w.x << 16), __builtin_bit_cast(float, w.x & 0xffff0000u), __builtin_bit_cast(float, w.y << 16), __builtin_bit_cast(float, w.y & 0xffff0000u)}; }
#pragma unroll
            for (int e = 0; e < 16; ++e) {
                const int slot = (int)(short)((sw[e >> 1] >> ((e & 1) * 16)) & 0xffffu);
                if (__builtin_amdgcn_readfirstlane(slot) >= 0) {
                    const GAS u32x2* yr = (const GAS u32x2*)(ye + ((size_t)(b * 16 + e) * CAP + slot) * DM) + lane;
#pragma unroll
                    for (int j = 0; j < 4; ++j) { const u32x2 w = yr[64 * j];
                        f[u][j].x += __builtin_bit_cast(float, w.x << 16); f[u][j].y += __builtin_bit_cast(float, w.x & 0xffff0000u); f[u][j].z += __builtin_bit_cast(float, w.y << 16); f[u][j].w += __builtin_bit_cast(float, w.y & 0xffff0000u); }
                }
            } }
        float ss[2] = {0.f, 0.f};
#pragma unroll
        for (int u = 0; u < 2; ++u)
#pragma unroll
            for (int j = 0; j < 4; ++j) ss[u] += (f[u][j].x * f[u][j].x + f[u][j].y * f[u][j].y) + (f[u][j].z * f[u][j].z + f[u][j].w * f[u][j].w);
        ss[0] = wave_sum(ss[0]); ss[1] = wave_sum(ss[1]);
#pragma unroll
        for (int u = 0; u < 2; ++u) { if (u == 1 && !v1) break;
            const int m = mm[u], b = m >> 13; const float rstd = __builtin_amdgcn_rsqf(ss[u] * (1.f / DM) + NORM_EPS);
            GAS f32x4* orow = (GAS f32x4*)(a.out + (size_t)m * DM) + lane;
#pragma unroll
            for (int j = 0; j < 4; ++j) { const int c = 4 * lane + 256 * j; const f32x4 p = *(const LAS f32x4*)(par + b * 1024 + c); orow[64 * j] = xo[u][j] + p * (f[u][j] * rstd); } }
    }
}


namespace ctxp {
constexpr int AST = 272;
constexpr int L_A = 0, L_B = 64 * AST, L_RED = 2 * 64 * AST;
__device__ __forceinline__ void tile(LAS unsigned char* lds, const bf16_t* hn, const bf16_t* wt, int t, bf16_t* P, bf16_t* KI, bf16_t* VI, const float* hglb) {
    const int tid = opaque_tid(), lane = tid & 63, hh = lane >> 5, r32 = lane & 31; const int wid = __builtin_amdgcn_readfirstlane(tid >> 6);
    const int rbk = t / 40, cb = t % 40, b = rbk >> 2;
    const int row0 = b * RB + (rbk & 3) * 64;
    const int col0 = 512 + cb * 64;
    const int lr = tid >> 4, lp = tid & 15;
    const GAS bf16_t* ag = (const GAS bf16_t*)(hn + (size_t)(row0 + lr) * DM + lp * 8);
    const GAS bf16_t* bg = (const GAS bf16_t*)(wt + (size_t)(col0 + lr) * DM + lp * 8);
    u32x4 ra0 = *(const GAS u32x4*)ag, ra1 = *(const GAS u32x4*)(ag + (size_t)32 * DM), rb0 = *(const GAS u32x4*)bg, rb1 = *(const GAS u32x4*)(bg + (size_t)32 * DM);
    const int rb2 = wid & 1, cb2 = (wid >> 1) & 1, kh = wid >> 2;
    f32x16 acc = {};
#pragma unroll 1
    for (int kc = 0; kc < 8; ++kc) {
        __syncthreads();
        *(LAS u32x4*)(lds + L_A + lr * AST + lp * 16) = ra0; *(LAS u32x4*)(lds + L_A + (lr + 32) * AST + lp * 16) = ra1;
        *(LAS u32x4*)(lds + L_B + lr * AST + lp * 16) = rb0; *(LAS u32x4*)(lds + L_B + (lr + 32) * AST + lp * 16) = rb1;
        if (kc < 7) { ra0 = *(const GAS u32x4*)(ag + (kc + 1) * 128); ra1 = *(const GAS u32x4*)(ag + (size_t)32 * DM + (kc + 1) * 128); rb0 = *(const GAS u32x4*)(bg + (kc + 1) * 128); rb1 = *(const GAS u32x4*)(bg + (size_t)32 * DM + (kc + 1) * 128); }
        __syncthreads();
#pragma unroll
        for (int ks = 0; ks < 4; ++ks) { const int ko = (kh * 64 + ks * 16 + hh * 8) * 2;
            const bf16x8 af = *(const LAS bf16x8*)(lds + L_A + (32 * rb2 + r32) * AST + ko), bf = *(const LAS bf16x8*)(lds + L_B + (32 * cb2 + r32) * AST + ko);
            acc = MFMA32(af, bf, acc); }
    }
    __syncthreads();
    LAS float* red = (LAS float*)(lds + L_RED) + (wid & 3) * 1024;
    if (kh == 1) {
#pragma unroll
        for (int r = 0; r < 16; ++r) red[r * 64 + lane] = acc[r]; }
    __syncthreads();
    if (kh == 0) {
        const int c = col0 + 32 * cb2 + r32;
        const int region = c >> 9;
        float lbv = 0.f;
        if (region == 3 || region == 4) { const int d = region - 3, cc = c & 511; lbv = 1.f / (1.f + __expf(hglb[1024 + d * 512 + cc] - hglb[d * 512 + cc])); }
#pragma unroll
        for (int r = 0; r < 16; ++r) {
            float v = acc[r] + red[r * 64 + lane];
            const int rr = (rbk & 3) * 64 + 32 * rb2 + att::crow(r, hh);
            if (region == 3 || region == 4) { const float sg = __builtin_amdgcn_rcpf(1.f + __expf(-v)); v = __builtin_amdgcn_logf(lbv + (1.f - lbv) * sg); }
            const bf16_t o = (bf16_t)cvt_pk_bf16(v, v);
            if (region == 1) { const int cK = c - 512, h = cK >> 7, comp = (cK >> 6) & 1, d = cK & 63;
                KI[((size_t)((b * 4 + h) * 132 + (rr >> 6))) * 8192 + (comp * 8 + (d >> 3)) * 512 + (rr & 63) * 8 + (d & 7)] = o; }
            else if (region == 2) { const int cV = c - 1024, h = cV >> 7, dv = cV & 127;
                VI[((size_t)((b * 4 + h) * 132 + (rr >> 6))) * 8192 + (dv >> 5) * 2048 + (rr & 63) * 32 + (dv & 31)] = o; }
            else P[(size_t)(b * RB + rr) * NPJ + (c - 1024)] = o;
        }
    }
    __syncthreads();
}
}

__global__ void __launch_bounds__(NWAVES * 64, 2) fwd_kernel(Args args) {
    extern __shared__ __attribute__((aligned(16))) unsigned char lds[];
    Frame F;
    F.lds = (LAS unsigned char*)lds;
    F.MISC = (volatile LAS unsigned*)(F.lds + MISC_OFF);
    F.tid = threadIdx.x; F.lane = F.tid & 63; F.wave = __builtin_amdgcn_readfirstlane(F.tid >> 6);
    F.G = gridDim.x; { const int bx = blockIdx.x; F.vcu = (F.G % 8 == 0) ? (bx % 8) * (F.G / 8) + bx / 8 : bx; }
    unsigned char* ws = args.ws;
    F.ctl = (gu32*)(ws + WS_CTL);
    for (int u = F.tid; u < (LDS_BYTES - LDSCTL_OFF) / 4; u += NWAVES * 64) ((LAS unsigned*)(F.lds + LDSCTL_OFF))[u] = 0u;
    __syncthreads();
    XcdBarrier bar = xcd_barrier_post((unsigned*)(F.ctl + CW_BAR), F.MISC + 8);
    const int lo = args.ph_lo, hi = args.ph_hi;
#define IN(k) (lo <= (k) && (k) < hi)
#define GRID_BAR() xcd_barrier(bar)

    if (IN(0)) { p0_prologue(F, args); GRID_BAR(); }
    if (IN(1)) { p1_norm(F, args); GRID_BAR(); }
    if (IN(2)) {
        for (int t = (int)blockIdx.x; t < 320; t += F.G) ctxp::tile(F.lds, (const bf16_t*)(ws + WS_HN), (const bf16_t*)(ws + WS_WIN), t, (bf16_t*)(ws + WS_PROJ), (bf16_t*)(ws + WS_KIMG), (bf16_t*)(ws + WS_VIMG), args.hglb);
        SchedInProj S; S.nM = ML / 256; S.nN = NIN / 256; S.nwg = S.nM * S.nN; S.G = F.G; S.c = (int)blockIdx.x; S.Bt = (const bf16_t*)(ws + WS_WIN); S.K = DM;
        EpiInProj E{(bf16_t*)(ws + WS_PROJ), (bf16_t*)(ws + WS_KIMG), (bf16_t*)(ws + WS_VIMG), (const f32x2*)(ws + WS_ROPE), args.hglb};
        pg8::gemm_phase<EpiInProj, SchedInProj, true>(F.lds, (const bf16_t*)(ws + WS_HN), DM, S, E);
        GRID_BAR();
    }
    if (IN(4)) {
        hg::h1_phase(F.lds, (const bf16_t*)(ws + WS_PROJ), (float*)(ws + WS_HGU), (float*)(ws + WS_HGD), F.vcu, F.G);
        GRID_BAR();
        hg::scan_phase((float*)(ws + WS_HGU), (const float*)(ws + WS_HGD), (int)(blockIdx.x * 512 + opaque_tid()));
        GRID_BAR();
    }
    if (IN(3)) {
        float lam;
        { float d1 = 0.f, d2 = 0.f;
          for (int i = 0; i < 64; ++i) { d1 += args.lq1[i] * args.lk1[i]; d2 += args.lq2[i] * args.lk2[i]; }
          lam = __expf(d1) - __expf(d2) + LAMBDA_INIT; }
        const int bh = blockIdx.x & 7, sub = blockIdx.x >> 3;
        for (int i = 0; i < 2; ++i) att2::attn_unit(F.lds, (const bf16_t*)(ws + WS_PROJ), (const bf16_t*)(ws + WS_KIMG), (const bf16_t*)(ws + WS_VIMG), (bf16_t*)args.out, bh >> 2, bh & 3, sub + 32 * i, lam, args.da_subln);
    }
    if (IN(5)) {
        for (int u = F.vcu; u < 256; u += F.G) hg::h3_unit(F.lds, (const bf16_t*)(ws + WS_PROJ), (const float*)(ws + WS_HGU), (bf16_t*)args.out, args.out + 8388608, args.hg_norm, u);
        GRID_BAR();
    }
    if (IN(6)) {
        SchedPlain S; S.nM = ML / 256; S.nN = DM / 256; S.nwg = S.nM * S.nN; S.G = F.G; S.c = (int)blockIdx.x; S.Bt = (const bf16_t*)(ws + WS_WOUT); S.K = DM;
        EpiYbf16 E{(bf16_t*)(ws + WS_YLAT), DM};
        pg8::gemm_phase<EpiYbf16, SchedPlain, false>(F.lds, (const bf16_t*)args.out, DM, S, E);
    }
    if (IN(7)) p7_pre(F, args);
    if (IN(6)) GRID_BAR();
    if (IN(7)) { p7_rowpass(F, args); GRID_BAR(); }
    if (IN(8)) {
        if (blockIdx.x < 32) topk_unit(F.lds, (const float*)(ws + WS_AFF), (int*)(ws + WS_SELIDX), (float*)(ws + WS_SELGATE), (short*)(ws + WS_SLOT), (int)blockIdx.x);
        else { const int t8 = opaque_tid(); convert_items(F, args, P0_ITEMS_EARLY, P0_ITEMS_ALL, ((int)blockIdx.x - 32) * NWAVES + (t8 >> 6), (F.G - 32) * NWAVES, __builtin_amdgcn_readfirstlane(t8 >> 6), t8 & 63); }
        GRID_BAR();
    }
    if (IN(9)) {
        SchedMoe1 S{(int)blockIdx.x, (const bf16_t*)(ws + WS_WGU), (const int*)(ws + WS_SELIDX)};
        EpiSwiglu E{ws + WS_HB};
        pg8::gemm_phase<EpiSwiglu, SchedMoe1, true, true>(F.lds, (const bf16_t*)(ws + WS_H2), DM, S, E);
        GRID_BAR();
    }
    if (IN(10)) {
        SchedMoe2 S{(int)blockIdx.x, (const bf16_t*)(ws + WS_WD)};
        EpiGateBf16 E{(bf16_t*)(ws + WS_YE), (const float*)(ws + WS_SELGATE)};
        pg8::gemm_phase<EpiGateBf16, SchedMoe2, true, true>(F.lds, (const bf16_t*)(ws + WS_HB), FFD, S, E);
    }
    if (IN(11)) p11_pre(F, args);
    if (IN(10)) GRID_BAR();
    if (IN(11)) p11_combine(F, args);
#undef IN
#undef GRID_BAR
}

extern "C" void kernel_launch(void* const* d_in, const int* in_sizes, int n_in, void* d_out, int out_size, void* d_ws, size_t ws_size, hipStream_t stream) {
    static int grid = 0;
    if (grid == 0) {
        if (n_in != 23 || in_sizes[0] != ML * DM || out_size != ML * DM || ws_size < WS_END) { fprintf(stderr, "kernel_launch: unexpected shapes (n_in %d, in0 %d, out %d, ws %zu)\n", n_in, n_in > 0 ? in_sizes[0] : -1, out_size, ws_size); grid = -1; return; }
        int dev = 0, cus = 0, per_cu = 0;
        if (hipGetDevice(&dev) != hipSuccess || hipDeviceGetAttribute(&cus, hipDeviceAttributeMultiprocessorCount, dev) != hipSuccess) { grid = -1; return; }
        if (hipFuncSetAttribute((const void*)fwd_kernel, hipFuncAttributeMaxDynamicSharedMemorySize, LDS_BYTES) != hipSuccess) { fprintf(stderr, "kernel_launch: hipFuncSetAttribute failed\n"); grid = -1; return; }
        if (hipOccupancyMaxActiveBlocksPerMultiprocessor(&per_cu, (const void*)fwd_kernel, NWAVES * 64, LDS_BYTES) != hipSuccess || per_cu < 1) { fprintf(stderr, "kernel_launch: occupancy query says %d blocks per CU\n", per_cu); (void)hipGetLastError(); grid = -1; return; }
        grid = cus;
    }
    if (grid < 0) return;
    if (hipMemsetAsync((char*)d_ws + WS_CTL, 0, CTL_ZERO_BYTES, stream) != hipSuccess) return;
    Args a{};
    const float** p = (const float**)&a;
    for (int i = 0; i < 23; ++i) p[i] = (const float*)d_in[i];
    a.out = (float*)d_out; a.ws = (unsigned char*)d_ws; a.ph_lo = 0; a.ph_hi = 12;
#if PROBE_PH >= 0
    a.ph_lo = 0; a.ph_hi = PROBE_PH + 1; hipLaunchKernelGGL(fwd_kernel, dim3(grid), dim3(NWAVES * 64), LDS_BYTES, stream, a);
    (void)hipMemsetAsync((char*)d_ws + WS_CTL, 0, CTL_ZERO_BYTES, stream);
    a.ph_lo = PROBE_PH; a.ph_hi = PROBE_PH + 1; hipLaunchKernelGGL(fwd_kernel, dim3(grid), dim3(NWAVES * 64), LDS_BYTES, stream, a);
    (void)hipMemsetAsync((char*)d_ws + WS_CTL, 0, CTL_ZERO_BYTES, stream);
    a.ph_lo = PROBE_PH + 1; a.ph_hi = 12; hipLaunchKernelGGL(fwd_kernel, dim3(grid), dim3(NWAVES * 64), LDS_BYTES, stream, a);
#else
    hipLaunchKernelGGL(fwd_kernel, dim3(grid), dim3(NWAVES * 64), LDS_BYTES, stream, a);
#endif
}
```

```cpp
#include <hip/hip_runtime.h>
#include <cstdio>
#include <cstdint>

#define LAS __attribute__((address_space(3)))
#define GAS __attribute__((address_space(1)))
typedef unsigned short bf16_t;
typedef short bf16x8 __attribute__((ext_vector_type(8)));
typedef short s16x4 __attribute__((ext_vector_type(4)));
typedef float f32x4 __attribute__((ext_vector_type(4)));
typedef float f32x2 __attribute__((ext_vector_type(2)));
typedef float f32x16 __attribute__((ext_vector_type(16)));
typedef unsigned u32x4 __attribute__((ext_vector_type(4)));
typedef unsigned u32x2 __attribute__((ext_vector_type(2)));
typedef unsigned u32x16 __attribute__((ext_vector_type(16)));
typedef GAS unsigned gu32;

constexpr int BATCH = 2, SEQ = 8192, CTXL = 256, DM = 1024, NIN = 4096, NPJ = 3072;
constexpr int RB = CTXL + SEQ;
constexpr int MR = BATCH * RB;
constexpr int ML = BATCH * SEQ;
constexpr int NEXP = 16, CAP = 1024, FFD = 1024;
constexpr float NORM_EPS = 1e-6f;
constexpr float QSCALE = 0.125f * 1.4426950408889634f;
constexpr float LAMBDA_INIT = 0.2f;

constexpr size_t MiB = 1u << 20;
constexpr size_t WS_CTL = 0, CTL_ZERO_BYTES = 1 * MiB;
constexpr size_t WS_MOD = 1 * MiB;
constexpr size_t WS_ROPE = 1 * MiB + 128 * 1024;
constexpr size_t WS_AFF = 2 * MiB;
constexpr size_t WS_SELIDX = 3 * MiB;
constexpr size_t WS_SELGATE = 3 * MiB + 128 * 1024;
constexpr size_t WS_SLOT = 3 * MiB + 512 * 1024;
constexpr size_t WS_HGD = 4 * MiB;
constexpr size_t WS_WIN = 5 * MiB;
constexpr size_t WS_WOUT = 13 * MiB;
constexpr size_t WS_WGU = 15 * MiB;
constexpr size_t WS_X1B = 47 * MiB;
constexpr size_t WS_WD = 79 * MiB;
constexpr size_t WS_PROJ = 111 * MiB;
constexpr size_t WS_KIMG = 210 * MiB;
constexpr size_t WS_VIMG = 210 * MiB + 17301504;
constexpr size_t WS_HN = 243 * MiB;
constexpr size_t WS_END = 276 * MiB;
constexpr size_t WS_YLAT = WS_PROJ;
constexpr size_t WS_HB = WS_PROJ;
constexpr size_t WS_YE = WS_PROJ + 64 * MiB;
constexpr size_t WS_HGU = WS_HN;
constexpr size_t WS_H2 = WS_HN;
constexpr int CW_BAR = 4096;
#ifndef PROBE_PH
#define PROBE_PH -1
#endif

constexpr int RING_BYTES = 143360, LDSCTL_OFF = RING_BYTES, MISC_OFF = LDSCTL_OFF + 320, LDS_BYTES = 147456;
constexpr int NWAVES = 8;

#define LDS_WAIT() asm volatile("s_waitcnt lgkmcnt(0)" ::: "memory")
#define VM_WAIT() asm volatile("s_waitcnt vmcnt(0)" ::: "memory")
#define RLX_AGENT __ATOMIC_RELAXED, __HIP_MEMORY_SCOPE_AGENT

__device__ __forceinline__ unsigned cvt_pk_bf16(float lo, float hi) { unsigned r; asm volatile("v_cvt_pk_bf16_f32 %0, %1, %2" : "=v"(r) : "v"(lo), "v"(hi)); return r; }
__device__ __forceinline__ unsigned cvt4_fp8(float a, float b, float c, float d) { int p = __builtin_amdgcn_cvt_pk_fp8_f32(a, b, 0, false); p = __builtin_amdgcn_cvt_pk_fp8_f32(c, d, p, true); return (unsigned)p; }
__device__ __forceinline__ float sat8(float v) { return __builtin_amdgcn_fmed3f(v, -448.f, 448.f); }
__device__ __forceinline__ unsigned cvt4_fp8_sat(float a, float b, float c, float d) { return cvt4_fp8(sat8(a), sat8(b), sat8(c), sat8(d)); }
constexpr float W8_SCALE = 32.f, W8_INV = 1.f / 32.f;
__device__ __forceinline__ unsigned f2bf(float f) { unsigned u = __builtin_bit_cast(unsigned, f); return (u + 0x7fffu + ((u >> 16) & 1u)) >> 16; }
__device__ __forceinline__ unsigned pk2(float lo, float hi) { return f2bf(lo) | (f2bf(hi) << 16); }
__device__ __forceinline__ float bf2f(unsigned short h) { return __builtin_bit_cast(float, (unsigned)h << 16); }
__device__ __forceinline__ int opaque_tid() { int t = threadIdx.x; asm volatile("" : "+v"(t)); return t; }
template <class T> __device__ __forceinline__ T* launder(T* p) { asm volatile("" : "+v"(p)); return p; }
template <class T> __device__ __forceinline__ GAS T* launder_g(T* p) { GAS T* g = (GAS T*)p; asm volatile("" : "+v"(g)); return g; }
__device__ __forceinline__ float half_sum32(float v) {
    v += __builtin_bit_cast(float, __builtin_amdgcn_update_dpp(0, __builtin_bit_cast(int, v), 0xB1, 0xf, 0xf, false));
    v += __builtin_bit_cast(float, __builtin_amdgcn_update_dpp(0, __builtin_bit_cast(int, v), 0x4E, 0xf, 0xf, false));
    v += __builtin_bit_cast(float, __builtin_amdgcn_update_dpp(0, __builtin_bit_cast(int, v), 0x141, 0xf, 0xf, false));
    v += __builtin_bit_cast(float, __builtin_amdgcn_update_dpp(0, __builtin_bit_cast(int, v), 0x140, 0xf, 0xf, false));
    v += __builtin_bit_cast(float, __builtin_amdgcn_ds_swizzle(__builtin_bit_cast(int, v), 0x401F));
    return v;
}
#define DPPF(x, ctl) __builtin_bit_cast(float, __builtin_amdgcn_update_dpp(0, __builtin_bit_cast(int, (x)), (ctl), 0xf, 0xf, false))
__device__ __forceinline__ float reduce16_row(const float (&v)[16], int lane) {
    const bool b3 = (lane & 8) != 0, b2 = (lane & 4) != 0, b1 = (lane & 2) != 0, b0 = (lane & 1) != 0;
    float w8[8], w4[4], w2[2];
#pragma unroll
    for (int k = 0; k < 8; ++k) { const float keep = b3 ? v[k + 8] : v[k], send = b3 ? v[k] : v[k + 8]; w8[k] = keep + DPPF(send, 0x140); }
#pragma unroll
    for (int k = 0; k < 4; ++k) { const float keep = b2 ? w8[k + 4] : w8[k], send = b2 ? w8[k] : w8[k + 4]; w4[k] = keep + DPPF(send, 0x141); }
#pragma unroll
    for (int k = 0; k < 2; ++k) { const float keep = b1 ? w4[k + 2] : w4[k], send = b1 ? w4[k] : w4[k + 2]; w2[k] = keep + DPPF(send, 0x4E); }
    const float keep = b0 ? w2[1] : w2[0], send = b0 ? w2[0] : w2[1];
    return keep + DPPF(send, 0xB1);
}
__device__ __forceinline__ float reduce16(const float (&v)[16], int lane) {
    float r = reduce16_row(v, lane);
    r += __builtin_bit_cast(float, __builtin_amdgcn_ds_swizzle(__builtin_bit_cast(int, r), 0x401F));
    return r + __shfl_xor(r, 32);
}
__device__ __forceinline__ float row_sum16(float v) { v += DPPF(v, 0xB1); v += DPPF(v, 0x4E); v += DPPF(v, 0x141); v += DPPF(v, 0x140); return v; }
__device__ __forceinline__ float row_max16(float v) { v = fmaxf(v, DPPF(v, 0xB1)); v = fmaxf(v, DPPF(v, 0x4E)); v = fmaxf(v, DPPF(v, 0x141)); v = fmaxf(v, DPPF(v, 0x140)); return v; }
__device__ __forceinline__ unsigned wave_sum_u(unsigned v) {
    v += (unsigned)__builtin_amdgcn_update_dpp(0, (int)v, 0xB1, 0xf, 0xf, false); v += (unsigned)__builtin_amdgcn_update_dpp(0, (int)v, 0x4E, 0xf, 0xf, false);
    v += (unsigned)__builtin_amdgcn_update_dpp(0, (int)v, 0x141, 0xf, 0xf, false); v += (unsigned)__builtin_amdgcn_update_dpp(0, (int)v, 0x140, 0xf, 0xf, false);
    v += (unsigned)__builtin_amdgcn_ds_swizzle((int)v, 0x401F);
    return v + (unsigned)__shfl_xor((int)v, 32);
}
__device__ __forceinline__ float xchg32(float v, bool lo) { unsigned a = __builtin_bit_cast(unsigned, v), b = a; asm volatile("" : "+v"(b)); const auto rr = __builtin_amdgcn_permlane32_swap(a, b, false, false); return __builtin_bit_cast(float, lo ? rr[1] : rr[0]); }
__device__ __forceinline__ float wave_sum(float v) {
    v = half_sum32(v);
    return v + __shfl_xor(v, 32);
}

namespace pg8 {
constexpr int BM = 256, BK = 64, HALF = 128, HTB = HALF * BK * 2, STAGE_BYTES = 8 * HTB, NXCD = 8, WGM = 8;
__host__ __device__ __forceinline__ int lds_byte(int r, int c) { const int st = (r >> 4) * 2 + (c >> 5), rr = r & 15, cc = c & 31, ob = rr * 64 + cc * 2; return st * 1024 + (ob ^ (((ob >> 9) & 1) << 5)); }
__host__ __device__ __forceinline__ void stage_rc(int b, int& R, int& C) { const int st = b / 1024, sb = b % 1024, swz = sb ^ (((sb >> 9) & 1) << 5); R = (st >> 1) * 16 + swz / 64; C = (st & 1) * 32 + (swz % 64) / 2; }
__host__ __device__ __forceinline__ int perm32(int rho) { const int n = rho >> 4, i = rho & 15; return 8 * (i >> 2) + 4 * n + (i & 3); }

struct Unit { int pm, pn, arow0, gadd; const int* gidx; const bf16_t* Bt; int aux; };

typedef int v8i_t __attribute__((ext_vector_type(8)));
typedef v8i_t v8i_a16 __attribute__((aligned(16)));
__device__ __forceinline__ void mma_block8(f32x4 (&c)[4][2], const v8i_t (&At)[4], const v8i_t (&Bt)[2]) {
#pragma unroll
    for (int m = 0; m < 4; ++m)
#pragma unroll
        for (int n = 0; n < 2; ++n) asm volatile("v_mfma_scale_f32_16x16x128_f8f6f4 %0, %1, %2, %0, %3, %3 op_sel_hi:[0,0,0]" : "+v"(c[m][n]) : "v"(Bt[n]), "v"(At[m]), "v"(0x7f7f7f7f));
}
__device__ __forceinline__ void mma_block(f32x4 (&c)[4][2], const bf16x8 (&At)[4][2], const bf16x8 (&Bt)[2][2]) {
#pragma unroll
    for (int m = 0; m < 4; ++m)
#pragma unroll
        for (int n = 0; n < 2; ++n)
#pragma unroll
            for (int k = 0; k < 2; ++k) c[m][n] = __builtin_amdgcn_mfma_f32_16x16x32_bf16(Bt[n][k], At[m][k], c[m][n], 0, 0, 0);
}
template <class Epi, class Sched, bool ALIGN_EPI, bool F8 = false>
__device__ __forceinline__ void gemm_phase(LAS unsigned char* lds, const bf16_t* Abase, int K, const Sched& S, const Epi& E) {
    const int tid = opaque_tid(), wid = __builtin_amdgcn_readfirstlane(tid >> 6), lane = tid & 63, wr = wid >> 2, wc = wid & 3, fr = lane & 15, fq = lane >> 4;
    const int rowb = F8 ? K : 2 * K;
    const int nt = rowb / 128;
    int Rr[2], Cc[2]; unsigned voffB[2];
#pragma unroll
    for (int i = 0; i < 2; ++i) { int R, C; stage_rc(tid * 16 + i * 8192, R, C); const int Rb = Epi::PERM ? ((R & ~31) + perm32(R & 31)) : R;
        Rr[i] = R; Cc[i] = C; voffB[i] = (unsigned)(Rb * rowb + C * 2); }
    const size_t kstep = (size_t)(BK * 2);
    const size_t hstep = (size_t)HALF * rowb;
    const unsigned ldsw = (unsigned)wid * 1024u;
    const int aoff = F8 ? lds_byte(wr * 64 + fr, fq * 16) : lds_byte(wr * 64 + fr, fq * 8), boff = F8 ? lds_byte(wc * 32 + fr, fq * 16) : lds_byte(wc * 32 + fr, fq * 8);
    constexpr int KOFF = F8 ? 16 : 1024;
#define PG8_SA(b, h) (((b) * 2 + (h)) * HTB)
#define PG8_SB(b, h) ((4 + (b) * 2 + (h)) * HTB)
#define PG8_STAGE2(bufoff, gbase, v0, v1) do { \
        __builtin_amdgcn_global_load_lds((const unsigned*)((const char*)(gbase) + (v0)), (LAS unsigned*)(lds + (bufoff) + ldsw), 16, 0, 0); \
        __builtin_amdgcn_global_load_lds((const unsigned*)((const char*)(gbase) + (v1)), (LAS unsigned*)(lds + (bufoff) + ldsw + 8192), 16, 0, 0); } while (0)
#define PG8_STAGEB(bufoff, gbase) PG8_STAGE2(bufoff, gbase, voffB[0], voffB[1])
#define PG8_LDA(dst, b, h) do { if constexpr (F8) { _Pragma("unroll") for (int m = 0; m < 4; ++m) dst##8[m] = *(const LAS v8i_a16*)(lds + PG8_SA(b, h) + aoff + m * 2048); } else { _Pragma("unroll") for (int m = 0; m < 4; ++m) _Pragma("unroll") for (int k = 0; k < 2; ++k) dst[m][k] = *(const LAS bf16x8*)(lds + PG8_SA(b, h) + aoff + m * 2048 + k * KOFF); } } while (0)
#define PG8_LDB(dst, b, h) do { if constexpr (F8) { _Pragma("unroll") for (int n = 0; n < 2; ++n) dst##8[n] = *(const LAS v8i_a16*)(lds + PG8_SB(b, h) + boff + n * 2048); } else { _Pragma("unroll") for (int n = 0; n < 2; ++n) _Pragma("unroll") for (int k = 0; k < 2; ++k) dst[n][k] = *(const LAS bf16x8*)(lds + PG8_SB(b, h) + boff + n * 2048 + k * KOFF); } } while (0)
#define PG8_MMA(ai, bj, At, Bt) do { __builtin_amdgcn_s_setprio(1); if constexpr (F8) mma_block8(acc[ai][bj], At##8, Bt##8); else mma_block(acc[ai][bj], At, Bt); __builtin_amdgcn_s_setprio(0); } while (0)
#define PG8_WAIT_V(n) asm volatile("s_waitcnt vmcnt(" #n ")" ::: "memory")
#define PG8_WAIT_L(n) asm volatile("s_waitcnt lgkmcnt(" #n ")" ::: "memory")
#define PG8_BAR __builtin_amdgcn_s_barrier()
#define PG8_SCHED __builtin_amdgcn_sched_barrier(0)
#define PG8_AOFF(u, VA) do { _Pragma("unroll") for (int h_ = 0; h_ < 2; ++h_) _Pragma("unroll") for (int i_ = 0; i_ < 2; ++i_) { const int rl_ = h_ * HALF + Rr[i_]; \
        const int gr_ = (u).gidx ? ((u).gadd + (u).gidx[rl_]) : ((u).arow0 + rl_); VA[h_][i_] = (unsigned)(gr_ * rowb + Cc[i_] * 2); } } while (0)
    Unit cur, nxt; int ui = 0;
    if (!S.next(0, cur)) return;
    f32x4 acc[2][2][4][2];
#pragma unroll
    for (int a = 0; a < 2; ++a)
#pragma unroll
        for (int b = 0; b < 2; ++b)
#pragma unroll
            for (int m = 0; m < 4; ++m)
#pragma unroll
                for (int n = 0; n < 2; ++n) acc[a][b][m][n] = (f32x4){0.f, 0.f, 0.f, 0.f};
    bf16x8 At[4][2], B0[2][2], B1[2][2]; v8i_t At8[4], B08[2], B18[2];
    unsigned cVA[2][2], nVA[2][2];
    PG8_AOFF(cur, cVA);
    const char* const A0 = (const char*)Abase;
    const char* cB = (const char*)cur.Bt;
    PG8_STAGEB(PG8_SB(0, 0), cB); PG8_STAGEB(PG8_SB(0, 1), cB + hstep); PG8_STAGE2(PG8_SA(0, 0), A0, cVA[0][0], cVA[0][1]); PG8_STAGE2(PG8_SA(0, 1), A0, cVA[1][0], cVA[1][1]);
    if (wr == 1) PG8_BAR;
    PG8_WAIT_V(2); PG8_BAR;
    PG8_STAGEB(PG8_SB(1, 0), cB + kstep); PG8_STAGE2(PG8_SA(1, 0), A0 + kstep, cVA[0][0], cVA[0][1]); PG8_STAGEB(PG8_SB(1, 1), cB + hstep + kstep);
    PG8_WAIT_V(6); PG8_BAR;
    for (;;) {
        const bool has_next = S.next(ui + 1, nxt);
        const char* nB = has_next ? (const char*)nxt.Bt : cB;
        if (has_next) { PG8_AOFF(nxt, nVA); } else {
#pragma unroll
            for (int h_ = 0; h_ < 2; ++h_)
#pragma unroll
                for (int i_ = 0; i_ < 2; ++i_) nVA[h_][i_] = cVA[h_][i_]; }
        for (int t = 0; t < nt; t += 2) {
            const bool last = (t == nt - 2);
            const char* a1 = A0 + (size_t)(t + 1) * kstep;
            const char* a2 = last ? A0 : A0 + (size_t)(t + 2) * kstep; const char* b2 = last ? nB : cB + (size_t)(t + 2) * kstep;
            const char* a3 = a2 + kstep; const char* b3 = b2 + kstep;
            const unsigned x00 = last ? nVA[0][0] : cVA[0][0], x01 = last ? nVA[0][1] : cVA[0][1], x10 = last ? nVA[1][0] : cVA[1][0], x11 = last ? nVA[1][1] : cVA[1][1];
            PG8_LDB(B0, 0, 0); PG8_LDB(B1, 0, 1); PG8_SCHED; PG8_LDA(At, 0, 0); PG8_STAGE2(PG8_SA(1, 1), a1, cVA[1][0], cVA[1][1]);
            PG8_WAIT_V(8); PG8_WAIT_L(0); PG8_BAR; PG8_MMA(0, 0, At, B0); PG8_MMA(0, 1, At, B1); PG8_BAR; PG8_SCHED;
            PG8_LDA(At, 0, 1); PG8_STAGEB(PG8_SB(0, 0), b2); PG8_STAGEB(PG8_SB(0, 1), b2 + hstep); PG8_STAGE2(PG8_SA(0, 0), a2, x00, x01);
            PG8_WAIT_V(8); PG8_WAIT_L(0); PG8_BAR; PG8_MMA(1, 0, At, B0); PG8_MMA(1, 1, At, B1); PG8_BAR; PG8_SCHED;
            PG8_LDB(B0, 1, 0); PG8_LDB(B1, 1, 1); PG8_SCHED; PG8_LDA(At, 1, 0); PG8_STAGE2(PG8_SA(0, 1), a2, x10, x11);
            PG8_WAIT_V(8); PG8_WAIT_L(0); PG8_BAR; PG8_MMA(0, 0, At, B0); PG8_MMA(0, 1, At, B1); PG8_BAR; PG8_SCHED;
            PG8_LDA(At, 1, 1); PG8_STAGEB(PG8_SB(1, 0), b3); PG8_STAGEB(PG8_SB(1, 1), b3 + hstep); PG8_STAGE2(PG8_SA(1, 0), a3, x00, x01);
            PG8_WAIT_V(8); PG8_WAIT_L(0); PG8_BAR; PG8_MMA(1, 0, At, B0); PG8_MMA(1, 1, At, B1); PG8_BAR; PG8_SCHED;
        }
        if constexpr (ALIGN_EPI) { if (wr == 0) PG8_BAR; }
        if constexpr (F8) asm volatile("s_nop 15\n\ts_nop 15" ::: "memory");
        E(acc, cur, wr, wc, fr, fq);
        if (!has_next) break;
#pragma unroll
        for (int a = 0; a < 2; ++a)
#pragma unroll
            for (int b = 0; b < 2; ++b)
#pragma unroll
                for (int m = 0; m < 4; ++m)
#pragma unroll
                    for (int n = 0; n < 2; ++n) acc[a][b][m][n] = (f32x4){0.f, 0.f, 0.f, 0.f};
        cur = nxt; cB = nB; ++ui;
#pragma unroll
        for (int h_ = 0; h_ < 2; ++h_)
#pragma unroll
            for (int i_ = 0; i_ < 2; ++i_) cVA[h_][i_] = nVA[h_][i_];
        if constexpr (ALIGN_EPI) { if (wr == 1) PG8_BAR; }
    }
    PG8_WAIT_V(0);
    if constexpr (!ALIGN_EPI) { if (wr == 0) PG8_BAR; }
    PG8_BAR;
#undef PG8_SA
#undef PG8_SB
#undef PG8_STAGE2
#undef PG8_STAGEB
#undef PG8_LDA
#undef PG8_LDB
#undef PG8_MMA
#undef PG8_WAIT_V
#undef PG8_WAIT_L
#undef PG8_BAR
#undef PG8_SCHED
#undef PG8_AOFF
}
}

#define XB_TMO      128
#define XB_XCNT(j)  (256  + 64 * (j))
#define XB_XSUB(j)  (1280 + 64 * (j))
#define XB_XGEN(j)  (2304 + 64 * (j))
#define XB_TOP      3328
#define XB_TOPGEN   3392
#define XCD_BAR_WORDS 3456
#define XB_SPIN_CAP (1u << 22)
__device__ __forceinline__ unsigned xb_ld(unsigned* p)              { return __hip_atomic_load(p, __ATOMIC_RELAXED, __HIP_MEMORY_SCOPE_AGENT); }
__device__ __forceinline__ unsigned xb_add(unsigned* p, unsigned v) { return __hip_atomic_fetch_add(p, v, __ATOMIC_RELAXED, __HIP_MEMORY_SCOPE_AGENT); }
__device__ __forceinline__ unsigned xb_xcc_id() { return (unsigned)__builtin_amdgcn_s_getreg((3 << 11) | 20) & 0xFu; }
#define XB_SPIN(cond, bar) do { unsigned _sp = 0; while (cond) { __builtin_amdgcn_s_sleep(1); \
    if ((++_sp & 255u) == 0u) { if (xb_ld(&(bar)[XB_TMO])) break; if (_sp > XB_SPIN_CAP) { atomicAdd(&(bar)[XB_TMO], 1u); break; } } } } while (0)
struct XcdBarrier { unsigned* bar; unsigned x; volatile LAS unsigned* st; };
__device__ __forceinline__ XcdBarrier xcd_barrier_post(unsigned* bar, volatile LAS unsigned* st) {
    XcdBarrier b; b.bar = bar; b.x = xb_xcc_id(); b.st = st;
    if (threadIdx.x == 0) (void)xb_add(&bar[XB_XCNT(b.x)], 1u);
    return b;
}
__device__ __forceinline__ void xcd_barrier_complete(unsigned* bar, unsigned x, unsigned& nloc, unsigned& nx) {
    const unsigned G = gridDim.x * gridDim.y * gridDim.z;
    unsigned sum, cnt, mine, sp = 0u;
    for (;;) {
        sum = 0u; cnt = 0u; mine = 0u;
#pragma unroll
        for (unsigned j = 0; j < 16; ++j) { const unsigned c = xb_ld(&bar[XB_XCNT(j)]); sum += c; cnt += (c > 0u) ? 1u : 0u; mine = (j == x) ? c : mine; }
        if (sum == G) break;
        __builtin_amdgcn_s_sleep(1);
        if ((++sp & 255u) == 0u) { if (xb_ld(&bar[XB_TMO])) break; if (sp > XB_SPIN_CAP) { atomicAdd(&bar[XB_TMO], 1u); break; } }
    }
    nloc = mine > 0u ? mine : 1u; nx = cnt > 0u ? cnt : 1u;
}
__device__ __forceinline__ void xcd_barrier(const XcdBarrier& b) {
    asm volatile("s_waitcnt vmcnt(0)" ::: "memory");
    __syncthreads();
    if (threadIdx.x == 0) {
        unsigned* bar = b.bar;
        __builtin_amdgcn_s_waitcnt(0);
        unsigned nloc = b.st[0], nx = b.st[1];
        if (nloc == 0u) { xcd_barrier_complete(bar, b.x, nloc, nx); b.st[0] = nloc; b.st[1] = nx; }
        const unsigned old = xb_add(&bar[XB_XSUB(b.x)], 1u);
        const unsigned gen = old / nloc;
        if (old + 1u == (gen + 1u) * nloc) {
            __builtin_amdgcn_fence(__ATOMIC_RELEASE, "agent");
            asm volatile("s_waitcnt vmcnt(0)" ::: "memory");
            const unsigned og = xb_add(&bar[XB_TOP], 1u);
            const unsigned tg = og / nx;
            if (og + 1u == (tg + 1u) * nx) xb_add(&bar[XB_TOPGEN], 1u);
            else XB_SPIN(xb_ld(&bar[XB_TOPGEN]) == tg, bar);
            __builtin_amdgcn_fence(__ATOMIC_ACQUIRE, "agent");
            xb_add(&bar[XB_XGEN(b.x)], 1u);
            asm volatile("s_waitcnt vmcnt(0)" ::: "memory");
        } else {
            XB_SPIN(xb_ld(&bar[XB_XGEN(b.x)]) == gen, bar);
            __builtin_amdgcn_fence(__ATOMIC_ACQUIRE, "agent");
            asm volatile("s_waitcnt vmcnt(0)" ::: "memory");
        }
    }
    __syncthreads();
}

struct Args {
    const float* x; const float* c; const float* ctx; const float* c_ctx; const float* w_ada; const float* b_ada;
    const float* n_pre_mix; const float* n_post_mix; const float* n_pre_ffn; const float* n_post_ffn;
    const float* w_in; const float* lq1; const float* lk1; const float* lq2; const float* lk2; const float* da_subln;
    const float* hglb; const float* hg_norm; const float* w_out; const float* w_router; const float* w_gate; const float* w_up; const float* w_down;
    float* out; unsigned char* ws; int ph_lo, ph_hi;
};

struct Frame {
    LAS unsigned char* lds; volatile LAS unsigned* MISC; gu32* ctl;
    int tid, lane, wave, vcu, G;
};

struct P0Item { const float* W; bf16_t* WT; int drow0; int ilv; int r; };
__device__ __forceinline__ void p0_item_load(const float* W, int N, int item, int lane, float (&wv)[32]) {
    const int nblk = N / 32, kb = item / nblk, nb = item % nblk, k0 = 64 * kb, n0 = 32 * nb;
    const GAS float* p = (const GAS float*)(W + (size_t)(k0 + (lane >> 5)) * N + n0 + (lane & 31));
#pragma unroll
    for (int i = 0; i < 32; ++i) wv[i] = p[(size_t)(2 * i) * N];
}
__device__ __forceinline__ void p0_item_store8(const float (&wv)[32], int K, int N, unsigned char* WT, int drow0, bool ilv, LAS float* scr, int item, int lane) {
    const int nblk = N / 32, kb = item / nblk, nb = item % nblk, k0 = 64 * kb, n0 = 32 * nb;
#pragma unroll
    for (int i = 0; i < 32; ++i) scr[(2 * i + (lane >> 5)) * 33 + (lane & 31)] = wv[i];
    LDS_WAIT(); asm volatile("" ::: "memory");
    const int c = lane & 7;
    const int dr = drow0 + (ilv ? ((n0 >> 7) * 256 + (n0 & 127)) : n0);
#pragma unroll
    for (int j = 0; j < 4; ++j) { const int n = (lane >> 3) + 8 * j; const LAS float* s = scr + (8 * c) * 33 + n;
        u32x2 o; o.x = cvt4_fp8(s[0 * 33] * W8_SCALE, s[1 * 33] * W8_SCALE, s[2 * 33] * W8_SCALE, s[3 * 33] * W8_SCALE); o.y = cvt4_fp8(s[4 * 33] * W8_SCALE, s[5 * 33] * W8_SCALE, s[6 * 33] * W8_SCALE, s[7 * 33] * W8_SCALE);
        *(GAS u32x2*)(WT + (size_t)(dr + n) * K + k0 + 8 * c) = o; }
    LDS_WAIT(); asm volatile("" ::: "memory");
}
__device__ __forceinline__ void p0_item_store(const float (&wv)[32], int K, int N, bf16_t* WT, int drow0, bool ilv, LAS float* scr, int item, int lane, bool rperm = false) {
    const int nblk = N / 32, kb = item / nblk, nb = item % nblk, k0 = 64 * kb, n0 = 32 * nb;
#pragma unroll
    for (int i = 0; i < 32; ++i) scr[(2 * i + (lane >> 5)) * 33 + (lane & 31)] = wv[i];
    LDS_WAIT(); asm volatile("" ::: "memory");
    const int c = lane & 7;
    const int dr = drow0 + (ilv ? ((n0 >> 7) * 256 + (n0 & 127)) : n0);
#pragma unroll
    for (int j = 0; j < 4; ++j) { const int n = (lane >> 3) + 8 * j; const LAS float* s = scr + (8 * c) * 33 + n;
        u32x4 o; o.x = cvt_pk_bf16(s[0 * 33], s[1 * 33]); o.y = cvt_pk_bf16(s[2 * 33], s[3 * 33]); o.z = cvt_pk_bf16(s[4 * 33], s[5 * 33]); o.w = cvt_pk_bf16(s[6 * 33], s[7 * 33]);
        const int nd = (rperm && n0 < 1024) ? (((n >> 2) & 3) * 8 + (n >> 4) * 4 + (n & 3)) : n;
        *(GAS u32x4*)(WT + (size_t)(dr + nd) * K + k0 + 8 * c) = o; }
    LDS_WAIT(); asm volatile("" ::: "memory");
}

__device__ __forceinline__ float silu_f(float v) { return v * __builtin_amdgcn_rcpf(1.f + __expf(-v)); }

constexpr int P0_I_IN = 16 * 128, P0_I_OUT = 16 * 32, P0_I_E = 16 * 32;
constexpr int P0_ITEMS_EARLY = P0_I_IN + P0_I_OUT + 2 * NEXP * P0_I_E, P0_ITEMS_ALL = P0_I_IN + P0_I_OUT + 3 * NEXP * P0_I_E;
__device__ __forceinline__ void convert_items(Frame& F, const Args& a, int lo, int hi, int gw, int NGW, int wave_, int lane_) {
    LAS float* scr = (LAS float*)(F.lds + wave_ * 16384);
    constexpr int I_IN = P0_I_IN, I_OUT = P0_I_OUT, I_E = P0_I_E;
    const int NITEMS = hi;
    bf16_t* win_t = (bf16_t*)(a.ws + WS_WIN); bf16_t* wout_t = (bf16_t*)(a.ws + WS_WOUT); unsigned char* wgu_t = a.ws + WS_WGU; unsigned char* wd_t = a.ws + WS_WD;
#define P0_DECODE(it_, W_, N_, WT_, D0_, ILV_, R_) do { int r_ = (it_); \
        if (r_ < I_IN) { W_ = a.w_in; N_ = 4096; WT_ = (unsigned char*)win_t; D0_ = 0; ILV_ = 4; R_ = r_; } \
        else if ((r_ -= I_IN) < I_OUT) { W_ = a.w_out; N_ = 1024; WT_ = (unsigned char*)wout_t; D0_ = 0; ILV_ = 0; R_ = r_; } \
        else { r_ -= I_OUT; const int mat_ = r_ / (NEXP * I_E); r_ -= mat_ * (NEXP * I_E); const int e_ = r_ / I_E; r_ -= e_ * I_E; N_ = 1024; R_ = r_; \
            if (mat_ == 0) { W_ = a.w_gate + (size_t)e_ * 1048576; WT_ = wgu_t + (size_t)e_ * 2097152; D0_ = 0; ILV_ = 3; } \
            else if (mat_ == 1) { W_ = a.w_up + (size_t)e_ * 1048576; WT_ = wgu_t + (size_t)e_ * 2097152; D0_ = 128; ILV_ = 3; } \
            else { W_ = a.w_down + (size_t)e_ * 1048576; WT_ = wd_t + (size_t)e_ * 1048576; D0_ = 0; ILV_ = 2; } } } while (0)
#define P0_STORE(wv_, N_, WT_, D0_, ILV_, R_) do { if ((ILV_) & 2) p0_item_store8(wv_, 1024, N_, WT_, D0_, ((ILV_) & 1) != 0, scr, R_, lane_); else p0_item_store(wv_, 1024, N_, (bf16_t*)(WT_), D0_, false, scr, R_, lane_, ((ILV_) & 4) != 0); } while (0)
    float wa[32], wb[32];
    const float* Wc; int Nc; unsigned char* WTc; int D0c; int ILVc; int Rc;
    int it = lo + gw;
    if (it < NITEMS) { P0_DECODE(it, Wc, Nc, WTc, D0c, ILVc, Rc); p0_item_load(Wc, Nc, Rc, lane_, wa); }
    while (it < NITEMS) {
        const int it1 = it + NGW; const float* W1 = Wc; int N1 = Nc; unsigned char* WT1 = WTc; int D01 = D0c; int ILV1 = ILVc; int R1 = Rc;
        if (it1 < NITEMS) { P0_DECODE(it1, W1, N1, WT1, D01, ILV1, R1); p0_item_load(W1, N1, R1, lane_, wb); }
        P0_STORE(wa, Nc, WTc, D0c, ILVc, Rc);
        if (it1 >= NITEMS) break;
        const int it2 = it1 + NGW;
        if (it2 < NITEMS) { P0_DECODE(it2, Wc, Nc, WTc, D0c, ILVc, Rc); p0_item_load(Wc, Nc, Rc, lane_, wa); }
        P0_STORE(wb, N1, WT1, D01, ILV1, R1);
        it = it2;
    }
#undef P0_DECODE
#undef P0_STORE
}

__device__ __forceinline__ void p0_prologue(Frame& F, const Args& a) {
    const int tid_ = opaque_tid(), lane_ = tid_ & 63; const int wave_ = __builtin_amdgcn_readfirstlane(tid_ >> 6);
    if (blockIdx.x < 96) {
        LAS float* sv = (LAS float*)(F.lds);
        LAS float* part = (LAS float*)(F.lds + 16384);
        for (int i = tid_; i < 3072; i += 512) { const int j = i >> 10, k = i & 1023; const float v = (j < 2) ? a.c[j * 1024 + k] : a.c_ctx[k]; sv[i] = silu_f(v); }
        __syncthreads();
        const int col = blockIdx.x * 64 + lane_; const int kb = wave_ * 128;
        float s0 = 0.f, s1 = 0.f, s2 = 0.f;
#pragma unroll 1
        for (int k0 = 0; k0 < 128; k0 += 32) {
            float w[32];
#pragma unroll
            for (int k = 0; k < 32; ++k) w[k] = a.w_ada[(size_t)(kb + k0 + k) * 6144 + col];
#pragma unroll
            for (int k = 0; k < 32; ++k) { s0 += sv[kb + k0 + k] * w[k]; s1 += sv[1024 + kb + k0 + k] * w[k]; s2 += sv[2048 + kb + k0 + k] * w[k]; }
        }
        part[(wave_ * 3 + 0) * 64 + lane_] = s0; part[(wave_ * 3 + 1) * 64 + lane_] = s1; part[(wave_ * 3 + 2) * 64 + lane_] = s2;
        __syncthreads();
        if (tid_ < 192) { const int j = tid_ >> 6, l = tid_ & 63; float s = a.b_ada[blockIdx.x * 64 + l];
#pragma unroll
            for (int w = 0; w < 8; ++w) s += part[(w * 3 + j) * 64 + l];
            ((float*)(a.ws + WS_MOD))[j * 6144 + blockIdx.x * 64 + l] = s; }
        __syncthreads();
    } else if (blockIdx.x == 96) {
        for (int e = tid_; e < 2048; e += 512) { const int pos = e >> 4, j = e & 15;
            const double inv = exp(-(double)j * (1.0 / 16.0) * 9.210340371976184); const double ang = (double)pos * inv;
            f32x2 v; v.x = (float)cos(ang); v.y = (float)sin(ang); ((f32x2*)(a.ws + WS_ROPE))[e] = v; }
    }
    convert_items(F, a, 0, P0_ITEMS_EARLY, F.vcu * NWAVES + wave_, F.G * NWAVES, wave_, lane_);
}

__device__ __forceinline__ void p1_norm(Frame& F, const Args& a) {
    const int tid_ = opaque_tid(), lane_ = tid_ & 63; const int wave_ = __builtin_amdgcn_readfirstlane(tid_ >> 6);
    LAS float* par = (LAS float*)F.lds;
    const float* mod = (const float*)(a.ws + WS_MOD);
    for (int i = tid_; i < 3072; i += 512) { const int v = i >> 10, c = i & 1023;
        par[v * 2048 + c] = a.n_pre_mix[c] * (1.f + mod[v * 6144 + 1024 + c]); par[v * 2048 + 1024 + c] = mod[v * 6144 + c]; }
    __syncthreads();
    bf16_t* hn = (bf16_t*)(a.ws + WS_HN);
    const bool cwg = false;
    const int gw = (int)blockIdx.x * NWAVES + wave_, NGW = F.G * NWAVES;
    const int nrows = MR;
    for (int q0 = gw; q0 < nrows; q0 += 2 * NGW) {
        const int q1 = q0 + NGW; const bool v1 = q1 < nrows;
        int Rr[2]; const float* srcp[2]; int var[2];
#pragma unroll
        for (int u = 0; u < 2; ++u) { const int q = (u == 0 || v1) ? (u ? q1 : q0) : q0;
            const int R = q; (void)cwg;
            const int b = R >= RB ? 1 : 0, rr = R - b * RB; const bool isctx = rr < CTXL;
            Rr[u] = R; srcp[u] = isctx ? a.ctx + (size_t)(b * CTXL + rr) * DM : a.x + (size_t)(b * SEQ + rr - CTXL) * DM; var[u] = isctx ? 2 : b; }
        f32x4 xv[2][4]; float ss[2] = {0.f, 0.f};
#pragma unroll
        for (int u = 0; u < 2; ++u) { const GAS f32x4* xr = (const GAS f32x4*)srcp[u] + lane_;
#pragma unroll
            for (int j = 0; j < 4; ++j) xv[u][j] = xr[64 * j]; }
#pragma unroll
        for (int u = 0; u < 2; ++u)
#pragma unroll
            for (int j = 0; j < 4; ++j) ss[u] += (xv[u][j].x * xv[u][j].x + xv[u][j].y * xv[u][j].y) + (xv[u][j].z * xv[u][j].z + xv[u][j].w * xv[u][j].w);
        ss[0] = wave_sum(ss[0]); ss[1] = wave_sum(ss[1]);
#pragma unroll
        for (int u = 0; u < 2; ++u) { if (u == 1 && !v1) break;
            const float rstd = __builtin_amdgcn_rsqf(ss[u] * (1.f / DM) + NORM_EPS);
            GAS unsigned long long* o8 = (GAS unsigned long long*)(hn + (size_t)Rr[u] * DM) + lane_;
#pragma unroll
            for (int j = 0; j < 4; ++j) { const int c = 4 * lane_ + 256 * j;
                const f32x4 sc = *(const LAS f32x4*)(par + var[u] * 2048 + c), sh = *(const LAS f32x4*)(par + var[u] * 2048 + 1024 + c);
                const f32x4 h = xv[u][j] * rstd * sc + sh;
                o8[64 * j] = (unsigned long long)cvt_pk_bf16(h.x, h.y) | ((unsigned long long)cvt_pk_bf16(h.z, h.w) << 32); } }
    }
    __syncthreads();
}

struct SchedInProj {
    int nM, nN, nwg, G, c; const bf16_t* Bt; int K;
    __device__ bool next(int i, pg8::Unit& u) const {
        const long L = (long)i * G + c; if (L >= nwg) return false;
        int wgid = (int)L; { const int q = nwg / 8, r = nwg % 8, xcd = wgid % 8, off = wgid / 8; wgid = (xcd < r ? xcd * (q + 1) : r * (q + 1) + (xcd - r) * q) + off; }
        const int nig = 8 * nN, gid = wgid / nig, fm = gid * 8, gsz = (nM - fm) < 8 ? (nM - fm) : 8;
        const int lt = fm + ((wgid % nig) % gsz);
        u.pm = lt + 1 + (lt >= 32 ? 1 : 0); u.pn = (wgid % nig) / gsz; u.arow0 = u.pm * 256; u.gadd = 0; u.gidx = nullptr; u.Bt = Bt + (size_t)u.pn * 256 * K; u.aux = 0; return true;
    }
};
struct EpiInProj {
    static constexpr bool PERM = true;
    bf16_t* P; bf16_t* KI; bf16_t* VI; const f32x2* cs; const float* hglb;
    __device__ __forceinline__ void operator()(const f32x4 (&acc)[2][2][4][2], const pg8::Unit& u, int wr, int wc, int fr, int fq) const {
        const int region = u.pn >> 1;
        const int b = (u.pm >= 33) ? 1 : 0; const bool isctx = (u.pm == 0 || u.pm == 33);
        if (isctx && (region == 0 || region >= 6)) return;
        const int pcol = (region == 0 ? u.pn * 256 : u.pn * 256 - 1024) + wc * 32 + 8 * fq;
        float lbv[2][8];
        if (region == 3 || region == 4) {
            const int d = region - 3;
#pragma unroll
            for (int bj = 0; bj < 2; ++bj) { const int cc = (u.pn & 1) * 256 + bj * 128 + wc * 32 + 8 * fq;
#pragma unroll
                for (int n = 0; n < 2; ++n) { const f32x4 a0 = *(const f32x4*)(hglb + d * 512 + cc + 4 * n), a1 = *(const f32x4*)(hglb + 1024 + d * 512 + cc + 4 * n);
#pragma unroll
                    for (int i = 0; i < 4; ++i) lbv[bj][4 * n + i] = __builtin_amdgcn_rcpf(1.f + __expf(a1[i] - a0[i])); } }
        }
#pragma unroll
        for (int ai = 0; ai < 2; ++ai)
#pragma unroll
            for (int m = 0; m < 4; ++m) {
                const int R = u.pm * 256 + ai * 128 + wr * 64 + m * 16 + fr;
                const int rr = R - b * RB, t = rr - CTXL;
#pragma unroll
                for (int bj = 0; bj < 2; ++bj) {
                    float v[8];
#pragma unroll
                    for (int i = 0; i < 4; ++i) { v[i] = acc[ai][bj][m][0][i]; v[4 + i] = acc[ai][bj][m][1][i]; }
                    if (region <= 1) {
                        if (!isctx) {
                            const int pos = (wc & 1) ? (t & 63) : (t >> 6);
                            const f32x4* cp = (const f32x4*)(cs + pos * 16 + 4 * fq);
                            const f32x4 c0 = cp[0], c1 = cp[1];
                            const float co[4] = {c0.x, c0.z, c1.x, c1.z}, si[4] = {c0.y, c0.w, c1.y, c1.w};
#pragma unroll
                            for (int i = 0; i < 4; ++i) { const float x1 = v[i], x2 = v[4 + i]; v[i] = x1 * co[i] - x2 * si[i]; v[4 + i] = x2 * co[i] + x1 * si[i]; }
                        }
                        if (region == 0) {
#pragma unroll
                            for (int i = 0; i < 8; ++i) v[i] *= QSCALE; }
                        u32x2 wl, wh; wl.x = cvt_pk_bf16(v[0], v[1]); wl.y = cvt_pk_bf16(v[2], v[3]); wh.x = cvt_pk_bf16(v[4], v[5]); wh.y = cvt_pk_bf16(v[6], v[7]);
                        if (region == 0) { bf16_t* qd = P + (size_t)R * NPJ + u.pn * 256 + bj * 128 + wc * 32 + 4 * fq; *(u32x2*)qd = wl; *(u32x2*)(qd + 16) = wh; }
                        else {
                            bf16_t* kd = KI + ((size_t)((b * 4 + (u.pn & 1) * 2 + bj) * 132 + (rr >> 6))) * 8192 + ((wc >> 1) * 8 + (wc & 1) * 4 + (fq >> 1)) * 512 + (rr & 63) * 8 + 4 * (fq & 1);
                            *(u32x2*)kd = wl; *(u32x2*)(kd + 1024) = wh; }
                        continue;
                    } else if (region == 3 || region == 4) {
#pragma unroll
                        for (int i = 0; i < 8; ++i) { const float lb = lbv[bj][i]; const float sg = __builtin_amdgcn_rcpf(1.f + __expf(-v[i])); v[i] = __builtin_amdgcn_logf(lb + (1.f - lb) * sg); }
                    } else if (region == 7) {
#pragma unroll
                        for (int i = 0; i < 8; ++i) v[i] = silu_f(v[i]);
                    }
                    u32x4 w; w.x = cvt_pk_bf16(v[0], v[1]); w.y = cvt_pk_bf16(v[2], v[3]); w.z = cvt_pk_bf16(v[4], v[5]); w.w = cvt_pk_bf16(v[6], v[7]);
                    if (region == 2) {
                        *(u32x4*)(VI + ((size_t)((b * 4 + (u.pn & 1) * 2 + bj) * 132 + (rr >> 6))) * 8192 + wc * 2048 + (rr & 63) * 32 + 8 * fq) = w;
                    } else *(u32x4*)(P + (size_t)R * NPJ + pcol + bj * 128) = w;
                }
            }
    }
};


namespace att {
constexpr int KSTR = 1040, KCOMP = 8 * KSTR, KBUF = 2 * KCOMP, VDB = 4160, VBUF = 4 * VDB, BUF = KBUF + VBUF;
constexpr int WSF_OFF = 2 * BUF;
__device__ __forceinline__ int crow(int r, int hi) { return (r & 3) + 8 * (r >> 2) + 4 * hi; }
__device__ __forceinline__ s16x4 vtr(LAS unsigned char* p) { typedef short v4i16_t __attribute__((ext_vector_type(4))); return __builtin_bit_cast(s16x4, __builtin_amdgcn_ds_read_tr16_b64_v4i16((LAS v4i16_t*)p)); }
#define MFMA32(a, b, c) __builtin_amdgcn_mfma_f32_32x32x16_bf16(a, b, c, 0, 0, 0)

}


namespace hg {
using att::vtr; using att::crow;
constexpr int COL_LF = 512, COL_V = 1536, COL_Q = 2048, COL_G = 2560;
constexpr int BS1 = 256 * 64;
constexpr int H1_K = 0, H1_V = 4 * BS1, H1_TOT = 8 * BS1;
#define HBAR() do { asm volatile("s_waitcnt lgkmcnt(0)" ::: "memory"); __builtin_amdgcn_s_barrier(); asm volatile("" ::: "memory"); } while (0)
__device__ __forceinline__ int seq_pos_to_sc(int dir, int p) { return (dir == 0 || p == 0) ? p : 33 - p; }

struct H1Regs { u32x16 lfa, lfb; u32x16 va, vb; };
__device__ __forceinline__ void h1_load(const bf16_t* P, int unit, int tid, H1Regs& R) {
    const int seq = unit >> 5, p = unit & 31, dir = seq & 1, h = (seq >> 1) & 3, b = seq >> 3;
    const int sc = seq_pos_to_sc(dir, p);
    const bf16_t* Pr = P + (size_t)(b * RB + sc * 256) * NPJ;
    const GAS char* bl = (const GAS char*)(Pr + COL_LF + dir * 512 + h * 128);
    unsigned off = (unsigned)(((tid >> 6) * 32) * NPJ + 2 * (tid & 63)) * 2u;
#pragma unroll
    for (int i = 0; i < 16; ++i) { R.lfa[i] = *(const GAS unsigned*)(bl + off); off += (unsigned)NPJ * 2u; asm volatile("" : "+v"(off)); }
#pragma unroll
    for (int i = 0; i < 16; ++i) { R.lfb[i] = *(const GAS unsigned*)(bl + off); off += (unsigned)NPJ * 2u; asm volatile("" : "+v"(off)); }
    const GAS char* bv = (const GAS char*)(Pr + COL_V + h * 128);
    unsigned voff = (unsigned)((tid >> 4) * NPJ + (tid & 15) * 8) * 2u;
#pragma unroll
    for (int i = 0; i < 4; ++i) { const u32x4 t_ = *(const GAS u32x4*)(bv + voff); R.va[4 * i] = t_.x; R.va[4 * i + 1] = t_.y; R.va[4 * i + 2] = t_.z; R.va[4 * i + 3] = t_.w; voff += 32u * (unsigned)NPJ * 2u; asm volatile("" : "+v"(voff)); }
#pragma unroll
    for (int i = 0; i < 4; ++i) { const u32x4 t_ = *(const GAS u32x4*)(bv + voff); R.vb[4 * i] = t_.x; R.vb[4 * i + 1] = t_.y; R.vb[4 * i + 2] = t_.z; R.vb[4 * i + 3] = t_.w; voff += 32u * (unsigned)NPJ * 2u; asm volatile("" : "+v"(voff)); }
}
__device__ __forceinline__ void h1_phase(LAS unsigned char* lds, const bf16_t* P, float* U, float* Dv, int first, int stride) {
    const int tid = opaque_tid(), lane = tid & 63, hh = lane >> 5, r32 = lane & 31; const int wid = __builtin_amdgcn_readfirstlane(tid >> 6);
    if (first >= 512) return;
    H1Regs R; h1_load(P, first, tid, R);
#pragma unroll 1
    for (int unit = first; unit < 512; unit += stride) {
        const int dir = (unit >> 5) & 1;
#pragma unroll
        for (int i = 0; i < 8; ++i) { const int pc = tid + 512 * i, s = pc >> 4, j = pc & 15;
            const u32x4 t_ = i < 4 ? (u32x4){R.va[4 * i], R.va[4 * i + 1], R.va[4 * i + 2], R.va[4 * i + 3]} : (u32x4){R.vb[4 * (i - 4)], R.vb[4 * (i - 4) + 1], R.vb[4 * (i - 4) + 2], R.vb[4 * (i - 4) + 3]};
            *(LAS u32x4*)(lds + H1_V + (j >> 2) * BS1 + s * 64 + (j & 3) * 16) = t_; }
        const int k = 2 * (tid & 63), rg = tid >> 6;
        float tota = 0.f, totb = 0.f;
#pragma unroll
        for (int i = 0; i < 16; ++i) { tota += __builtin_bit_cast(float, R.lfa[i] << 16) + __builtin_bit_cast(float, R.lfb[i] << 16); totb += __builtin_bit_cast(float, R.lfa[i] & 0xffff0000u) + __builtin_bit_cast(float, R.lfb[i] & 0xffff0000u); }
        LAS float* totl = (LAS float*)(lds + H1_TOT);
        *(LAS f32x2*)(totl + rg * 128 + k) = (f32x2){tota, totb};
        HBAR();
        float basea = 0.f, baseb = 0.f, alla = 0.f, allb = 0.f;
#pragma unroll
        for (int g = 0; g < 8; ++g) { const f32x2 tg = *(const LAS f32x2*)(totl + g * 128 + k); alla += tg.x; allb += tg.y; basea += (g < rg) ? tg.x : 0.f; baseb += (g < rg) ? tg.y : 0.f; }
        LAS unsigned char* kimg = lds + H1_K + (k >> 5) * BS1 + (k & 31) * 2 + (rg * 32) * 64;
        f32x2 base2 = {basea, baseb}; const f32x2 all2 = {alla, allb};
#define H1_ROW(LF, i, row) do { \
            const f32x2 l2 = {__builtin_bit_cast(float, LF[i] << 16), __builtin_bit_cast(float, LF[i] & 0xffff0000u)}; \
            const f32x2 kk = 1.f - (f32x2){__builtin_amdgcn_exp2f(l2.x), __builtin_amdgcn_exp2f(l2.y)}; \
            f32x2 w; \
            if (dir == 0) { base2 += l2; const f32x2 d_ = all2 - base2; w = (f32x2){__builtin_amdgcn_exp2f(d_.x), __builtin_amdgcn_exp2f(d_.y)}; } \
            else { w = (f32x2){__builtin_amdgcn_exp2f(base2.x), __builtin_amdgcn_exp2f(base2.y)}; base2 += l2; } \
            const f32x2 kw = kk * w; \
            *(LAS unsigned*)(kimg + (row) * 64) = cvt_pk_bf16(kw.x, kw.y); } while (0)
#pragma unroll
        for (int i = 0; i < 16; ++i) H1_ROW(R.lfa, i, i);
#pragma unroll
        for (int i = 0; i < 16; ++i) H1_ROW(R.lfb, i, 16 + i);
#undef H1_ROW
        if (rg == 0) *(f32x2*)(Dv + (size_t)unit * 128 + k) = (f32x2){__builtin_amdgcn_exp2f(alla), __builtin_amdgcn_exp2f(allb)};
        if (unit + stride < 512) h1_load(P, unit + stride, tid, R);
        HBAR();
        const int vb = wid & 3, kb0 = 2 * (wid >> 2);
        const int trb = ((lane >> 4) & 1) * 32 + (lane & 3) * 8 + (8 * hh + ((lane & 15) >> 2)) * 64;
        f32x16 u0 = {}, u1 = {};
#pragma unroll 4
        for (int ks = 0; ks < 16; ++ks) {
            LAS unsigned char* vp = lds + H1_V + vb * BS1 + trb + ks * 1024; const s16x4 vl = vtr(vp), vh = vtr(vp + 256);
            const bf16x8 vf = {vl[0], vl[1], vl[2], vl[3], vh[0], vh[1], vh[2], vh[3]};
            LAS unsigned char* ap = lds + H1_K + kb0 * BS1 + trb + ks * 1024; const s16x4 al = vtr(ap), ah = vtr(ap + 256), bl = vtr(ap + BS1), bh = vtr(ap + BS1 + 256);
            const bf16x8 a0 = {al[0], al[1], al[2], al[3], ah[0], ah[1], ah[2], ah[3]}, a1 = {bl[0], bl[1], bl[2], bl[3], bh[0], bh[1], bh[2], bh[3]};
            u0 = MFMA32(a0, vf, u0); u1 = MFMA32(a1, vf, u1);
        }
#pragma unroll
        for (int g4 = 0; g4 < 4; ++g4) { GAS float* up0 = launder_g(U + (size_t)unit * 16384 + vb * 32 + r32 + (size_t)(kb0 * 32 + 8 * g4 + 4 * hh) * 128);
#pragma unroll
            for (int i = 0; i < 4; ++i) { up0[i * 128] = u0[4 * g4 + i]; up0[(32 + i) * 128] = u1[4 * g4 + i]; } }
        HBAR();
    }
}

__device__ __forceinline__ void scan_phase(float* U, const float* Dv, int gtid) {
    const int seq = gtid >> 13, k = (gtid >> 6) & 127, v = (gtid & 63) * 2;
    if (seq >= 16) return;
    f32x2 S = {0.f, 0.f};
    float* up = U + (size_t)seq * 32 * 16384 + k * 128 + v; const float* dp = Dv + (size_t)seq * 32 * 128 + k;
    f32x2 uu[32]; float dd[32];
#pragma unroll
    for (int p = 0; p < 32; ++p) { uu[p] = *(const GAS f32x2*)(up + (size_t)p * 16384); dd[p] = *(const GAS float*)(dp + p * 128); }
#pragma unroll
    for (int p = 0; p < 32; ++p) { S = S * dd[p] + uu[p]; *(GAS f32x2*)(up + (size_t)p * 16384) = S; }
}

constexpr int BS3 = 4160, PST = 144;
constexpr int D_Q = 0, D_K = 4 * BS3, D_V = 8 * BS3, D_P = 12 * BS3, D_TOT = D_P + 64 * PST, D_VEC = D_TOT + 2048, D_NP = D_VEC + 1536, DSZ = 65536;
static_assert(D_NP + 1024 + 256 <= DSZ, "H3 LDS block");

__device__ __forceinline__ void h3_load(const bf16_t* Pc, bool bwd, int h, int t4, u32x16& lfw, u32x16& qw, u32x16& vr) {
    const int k = 2 * (t4 & 63), rg = t4 >> 6;
    const GAS char* bl = (const GAS char*)(Pc + COL_LF + (bwd ? 512 : 0) + h * 128);
    const GAS char* bq = (const GAS char*)(Pc + COL_Q + h * 128);
    unsigned off = (unsigned)((rg * 16) * NPJ + k) * 2u;
#pragma unroll
    for (int i = 0; i < 16; ++i) { lfw[i] = *(const GAS unsigned*)(bl + off); qw[i] = *(const GAS unsigned*)(bq + off); off += (unsigned)NPJ * 2u; asm volatile("" : "+v"(off)); }
    const GAS char* bv = (const GAS char*)(Pc + COL_V + h * 128);
    unsigned voff = (unsigned)((t4 >> 4) * NPJ + (t4 & 15) * 8) * 2u;
#pragma unroll
    for (int i = 0; i < 4; ++i) { const u32x4 t_ = *(const GAS u32x4*)(bv + voff); vr[4 * i] = t_.x; vr[4 * i + 1] = t_.y; vr[4 * i + 2] = t_.z; vr[4 * i + 3] = t_.w; voff += 16u * (unsigned)NPJ * 2u; asm volatile("" : "+v"(voff)); }
}

__device__ __forceinline__ void h3_step(LAS unsigned char* L, bool bwd, const bf16_t* Pn, bool nbwd, int h, int t4_, int vb, int lane_,
                                        u32x16& lfw, u32x16& qw, u32x16& vr, f32x16 (&o)[2], f32x16 (&S)[4]) {
    int t4 = t4_, lane = lane_; asm volatile("" : "+v"(t4), "+v"(lane));
    const int hh = lane >> 5, r32 = lane & 31;
#pragma unroll
    for (int i = 0; i < 4; ++i) { const int pc = t4 + 256 * i, s = pc >> 4, j = pc & 15; *(LAS u32x4*)(L + D_V + (j >> 2) * BS3 + s * 64 + (j & 3) * 16) = (u32x4){vr[4 * i], vr[4 * i + 1], vr[4 * i + 2], vr[4 * i + 3]}; }
    const int k = 2 * (t4 & 63), rg = t4 >> 6;
    float tota = 0.f, totb = 0.f;
#pragma unroll
    for (int i = 0; i < 16; ++i) { tota += __builtin_bit_cast(float, lfw[i] << 16); totb += __builtin_bit_cast(float, lfw[i] & 0xffff0000u); }
    LAS float* totl = (LAS float*)(L + D_TOT);
    *(LAS f32x2*)(totl + rg * 128 + k) = (f32x2){tota, totb};
    HBAR();
    float bca = 0.f, bcb = 0.f, alla = 0.f, allb = 0.f;
#pragma unroll
    for (int g = 0; g < 4; ++g) { const f32x2 tg = *(const LAS f32x2*)(totl + g * 128 + k);
        alla += tg.x; allb += tg.y;
        const bool before = bwd ? (g > rg) : (g < rg); bca += before ? tg.x : 0.f; bcb += before ? tg.y : 0.f; }
    LAS unsigned char* qimg = L + D_Q + (k >> 5) * BS3 + (k & 31) * 2 + (rg * 16) * 64;
    LAS unsigned char* kimg = L + D_K + (k >> 5) * BS3 + (k & 31) * 2 + (rg * 16) * 64;
    f32x2 bc = {bca - alla, bcb - allb};
#define H3_ROW(i) do { \
        const f32x2 l2 = {__builtin_bit_cast(float, lfw[i] << 16), __builtin_bit_cast(float, lfw[i] & 0xffff0000u)}; \
        const f32x2 qv = {__builtin_bit_cast(float, qw[i] << 16), __builtin_bit_cast(float, qw[i] & 0xffff0000u)}; \
        bc += l2; \
        const f32x2 e = {__builtin_amdgcn_exp2f(bc.x), __builtin_amdgcn_exp2f(bc.y)}; \
        const f32x2 kk = 1.f - (f32x2){__builtin_amdgcn_exp2f(l2.x), __builtin_amdgcn_exp2f(l2.y)}; \
        const f32x2 qe = qv * e, ke = kk * (f32x2){__builtin_amdgcn_rcpf(e.x), __builtin_amdgcn_rcpf(e.y)}; \
        *(LAS unsigned*)(qimg + (i) * 64) = cvt_pk_bf16(qe.x, qe.y); \
        *(LAS unsigned*)(kimg + (i) * 64) = cvt_pk_bf16(ke.x, ke.y); } while (0)
    if (bwd) {
#pragma unroll
        for (int ii = 0; ii < 16; ++ii) H3_ROW(15 - ii);
    } else {
#pragma unroll
        for (int ii = 0; ii < 16; ++ii) H3_ROW(ii);
    }
#undef H3_ROW
    LAS float* vec = (LAS float*)(L + D_VEC);
    if (rg == 0) *(LAS f32x2*)(vec + k) = (f32x2){__builtin_amdgcn_exp2f(alla), __builtin_amdgcn_exp2f(allb)};
    asm volatile("" ::: "memory");
    h3_load(Pn, nbwd, h, t4, lfw, qw, vr);
    HBAR();
#pragma unroll
    for (int kb = 0; kb < 4; ++kb)
#pragma unroll
        for (int g4 = 0; g4 < 4; ++g4) { const f32x4 d4 = *(const LAS f32x4*)(vec + kb * 32 + 8 * g4 + 4 * hh);
#pragma unroll
            for (int i = 0; i < 4; ++i) S[kb][4 * g4 + i] *= d4[i]; }
    {
        const int sb = vb & 1, rb = vb >> 1;
        f32x16 sc = {};
#pragma unroll
        for (int ks = 0; ks < 8; ++ks) { const int off = (ks >> 1) * BS3 + (ks & 1) * 32 + hh * 16;
            const bf16x8 a = *(const LAS bf16x8*)(L + D_K + off + (32 * sb + r32) * 64), bq = *(const LAS bf16x8*)(L + D_Q + off + (32 * rb + r32) * 64);
            sc = MFMA32(a, bq, sc); }
        const int rr = 32 * rb + r32;
        const int d0 = bwd ? (rr - 32 * sb - 4 * hh) : (32 * sb + 4 * hh - rr);
#pragma unroll
        for (int g = 0; g < 4; ++g) { const int s0 = 32 * sb + 8 * g + 4 * hh; float pv[4];
#pragma unroll
            for (int i = 0; i < 4; ++i) { const int cgi = 8 * g + i; const bool keep = d0 <= (bwd ? cgi : -cgi); pv[i] = keep ? sc[4 * g + i] : 0.f; }
            u32x2 w; w.x = cvt_pk_bf16(pv[0], pv[1]); w.y = cvt_pk_bf16(pv[2], pv[3]);
            *(LAS u32x2*)(L + D_P + rr * PST + s0 * 2) = w; }
    }
#pragma unroll
    for (int kb = 0; kb < 4; ++kb)
#pragma unroll
        for (int s = 0; s < 2; ++s) {
            u32x4 bw; bw.x = cvt_pk_bf16(S[kb][8 * s], S[kb][8 * s + 1]); bw.y = cvt_pk_bf16(S[kb][8 * s + 2], S[kb][8 * s + 3]); bw.z = cvt_pk_bf16(S[kb][8 * s + 4], S[kb][8 * s + 5]); bw.w = cvt_pk_bf16(S[kb][8 * s + 6], S[kb][8 * s + 7]);
            const bf16x8 bf = __builtin_bit_cast(bf16x8, bw);
#pragma unroll
            for (int rb = 0; rb < 2; ++rb) {
                LAS unsigned char* ap = L + D_Q + kb * BS3 + (32 * rb + r32) * 64 + (16 * s + 4 * hh) * 2;
                const u32x2 a0 = *(const LAS u32x2*)ap, a1 = *(const LAS u32x2*)(ap + 16);
                const u32x4 aw = {a0.x, a0.y, a1.x, a1.y};
                o[rb] = MFMA32(__builtin_bit_cast(bf16x8, aw), bf, o[rb]); }
        }
    HBAR();
    const int trb = ((lane >> 4) & 1) * 32 + (lane & 3) * 8 + (8 * hh + ((lane & 15) >> 2)) * 64;
    bf16x8 vf[4];
#pragma unroll
    for (int ks = 0; ks < 4; ++ks) { LAS unsigned char* vp = L + D_V + vb * BS3 + trb + ks * 1024; const s16x4 vl = vtr(vp), vh = vtr(vp + 256);
        vf[ks] = (bf16x8){vl[0], vl[1], vl[2], vl[3], vh[0], vh[1], vh[2], vh[3]}; }
#pragma unroll
    for (int rb = 0; rb < 2; ++rb)
#pragma unroll
        for (int ks = 0; ks < 4; ++ks) { const bf16x8 pa = *(const LAS bf16x8*)(L + D_P + (32 * rb + r32) * PST + ks * 32 + hh * 16); o[rb] = MFMA32(pa, vf[ks], o[rb]); }
#pragma unroll
    for (int kb = 0; kb < 4; ++kb)
#pragma unroll
        for (int ks = 0; ks < 4; ++ks) { LAS unsigned char* ap = L + D_K + kb * BS3 + trb + ks * 1024; const s16x4 al = vtr(ap), ah = vtr(ap + 256);
            const bf16x8 a0 = {al[0], al[1], al[2], al[3], ah[0], ah[1], ah[2], ah[3]}; S[kb] = MFMA32(a0, vf[ks], S[kb]); }
    HBAR();
}

__device__ __forceinline__ void h3_unit(LAS unsigned char* lds, const bf16_t* P, const float* U, bf16_t* mix, float* ofw  , const float* hg_norm, int unit) {
    const int tid = opaque_tid(), lane = tid & 63, hh = lane >> 5, r32 = lane & 31; const int wid = __builtin_amdgcn_readfirstlane(tid >> 6);
    const int dir = wid >> 2, vb = wid & 3, t4 = tid & 255;
    const bool bwd = dir != 0;
    const int sc = 1 + (unit & 31), h = (unit >> 5) & 3, b = unit >> 7;
    const bf16_t* Pr = P + (size_t)(b * RB + sc * 256) * NPJ;
    LAS unsigned char* L = lds + dir * DSZ;
    const GAS char* ofb = (const GAS char*)(ofw + (size_t)unit * 32768 + vb * 32);
    f32x16 S[4];
    { const float* Us = U + ((size_t)(((b * 4 + h) * 2 + dir) * 32 + (bwd ? 32 - sc : sc - 1))) * 16384 + vb * 32 + r32;
#pragma unroll
      for (int kb = 0; kb < 4; ++kb)
#pragma unroll
        for (int g4 = 0; g4 < 4; ++g4) { const GAS float* up = launder_g(Us + (size_t)(kb * 32 + 8 * g4 + 4 * hh) * 128);
#pragma unroll
            for (int i = 0; i < 4; ++i) S[kb][4 * g4 + i] = up[i * 128]; } }
    u32x16 lfw, qw, vr;
    h3_load(Pr + (size_t)(bwd ? 192 : 0) * NPJ, bwd, h, t4, lfw, qw, vr);
    const float gn = hg_norm[vb * 32 + r32];
    const int t0 = (sc - 1) * 256;
    LAS float* np = (LAS float*)(L + D_NP);
#pragma unroll 1
    for (int st = 0; st < 4; ++st) {
        const int c = bwd ? 3 - st : st, cn = st < 3 ? (bwd ? c - 1 : c + 1) : c;
        f32x16 o[2];
        if (st < 2) { o[0] = f32x16{}; o[1] = f32x16{}; }
        else {
#pragma unroll
            for (int rb = 0; rb < 2; ++rb)
#pragma unroll
                for (int g4 = 0; g4 < 4; ++g4) { unsigned oo = (unsigned)((64 * c + 4 * hh + 32 * rb + 8 * g4) * 128 + r32) * 4u; asm volatile("" : "+v"(oo));
#pragma unroll
                    for (int i = 0; i < 4; ++i) o[rb][4 * g4 + i] = *(const GAS float*)(ofb + oo + i * 512); }
        }
        h3_step(L, bwd, Pr + (size_t)(64 * cn) * NPJ, bwd, h, t4, vb, lane, lfw, qw, vr, o, S);
        if (st < 2) {
#pragma unroll
            for (int rb = 0; rb < 2; ++rb)
#pragma unroll
                for (int g4 = 0; g4 < 4; ++g4) { unsigned oo = (unsigned)((64 * c + 4 * hh + 32 * rb + 8 * g4) * 128 + r32) * 4u; asm volatile("" : "+v"(oo));
#pragma unroll
                    for (int i = 0; i < 4; ++i) *(GAS float*)((GAS char*)ofb + oo + i * 512) = o[rb][4 * g4 + i]; asm volatile("" ::: "memory"); }
            if (st == 1) { VM_WAIT(); HBAR(); }
        } else {
            {
                const bool b4 = (lane & 16) != 0, b3 = (lane & 8) != 0, b2 = (lane & 4) != 0, b1 = (lane & 2) != 0, b0 = (lane & 1) != 0;
#define H3_W16(k) ({ const float q0_ = o[0][k] * o[0][k], q1_ = o[1][k] * o[1][k]; const float keep_ = b4 ? q1_ : q0_, send_ = b4 ? q0_ : q1_; \
                     keep_ + __builtin_bit_cast(float, __builtin_amdgcn_ds_swizzle(__builtin_bit_cast(int, send_), 0x401F)); })
                float w8[8], w4[4], w2[2];
#pragma unroll
                for (int k = 0; k < 8; ++k) { const float lo_ = H3_W16(k), hi_ = H3_W16(k + 8); const float keep = b3 ? hi_ : lo_, send = b3 ? lo_ : hi_; w8[k] = keep + DPPF(send, 0x140); }
#undef H3_W16
#pragma unroll
                for (int k = 0; k < 4; ++k) { const float keep = b2 ? w8[k + 4] : w8[k], send = b2 ? w8[k] : w8[k + 4]; w4[k] = keep + DPPF(send, 0x141); }
#pragma unroll
                for (int k = 0; k < 2; ++k) { const float keep = b1 ? w4[k + 2] : w4[k], send = b1 ? w4[k] : w4[k + 2]; w2[k] = keep + DPPF(send, 0x4E); }
                const float tot = (b0 ? w2[1] : w2[0]) + DPPF(b0 ? w2[0] : w2[1], 0xB1);
                np[(32 * ((lane >> 4) & 1) + crow(lane & 15, hh)) * 4 + vb] = tot; }
            unsigned short gv[2][16];
            { const GAS char* bg = (const GAS char*)(Pr + COL_G + h * 128 + vb * 32);
              unsigned goff = (unsigned)((64 * c + 4 * hh) * NPJ + r32) * 2u;
#pragma unroll
              for (int rb = 0; rb < 2; ++rb)
#pragma unroll
                for (int g4 = 0; g4 < 4; ++g4)
#pragma unroll
                    for (int i = 0; i < 4; ++i) { gv[rb][4 * g4 + i] = *(const GAS unsigned short*)(bg + goff); goff += (unsigned)((i < 3 ? 1 : 5) * NPJ * 2); asm volatile("" : "+v"(goff)); } }
            HBAR();
            LAS float* rsl = np + 256;
            if (vb == 0) { const f32x4 q4 = *(const LAS f32x4*)(np + lane * 4); rsl[lane] = __builtin_amdgcn_rsqf(((q4.x + q4.y) + (q4.z + q4.w)) * (1.f / 128.f) + NORM_EPS); }
            HBAR();
#pragma unroll
            for (int rb = 0; rb < 2; ++rb)
#pragma unroll
                for (int g4 = 0; g4 < 4; ++g4) {
                    GAS bf16_t* mp = launder_g(mix + (size_t)(b * SEQ + t0 + 64 * c + 4 * hh + 32 * rb + 8 * g4) * DM + 512 + h * 128 + vb * 32 + r32);
                    const f32x4 r4 = *(const LAS f32x4*)(rsl + 32 * rb + 8 * g4 + 4 * hh);
#pragma unroll
                    for (int i = 0; i < 4; ++i) { const int r = 4 * g4 + i;
                        const float ov = o[rb][r] * r4[i] * gn * bf2f(gv[rb][r]); mp[(size_t)i * DM] = (bf16_t)cvt_pk_bf16(ov, ov); } }
        }
    }
    __syncthreads();
}
}


namespace att2 {
using att::crow; using att::vtr;
constexpr int KSTR = 1040, KCOMP = 8 * KSTR, KBUF = 2 * KCOMP, VDB = 4160, VBUF = 4 * VDB;
constexpr int LDS_K = 0, LDS_V = 4 * KBUF, LDS_WS = LDS_V + 3 * VBUF;
constexpr int NT = RB / 64;
#define SBAR() __builtin_amdgcn_sched_barrier(0)
#define PIN(x) asm volatile("" : "+v"(x))
#define WAIT_BAR(N) asm volatile("s_waitcnt vmcnt(" #N ") lgkmcnt(0)\n\ts_barrier" ::: "memory")
__device__ __forceinline__ void glds16(const void* g, unsigned lds_base) {
    asm volatile("s_mov_b32 m0, %1\n\ts_nop 0\n\tglobal_load_lds_dwordx4 %0, off" :: "v"(g), "s"(lds_base) : "memory", "m0"); }
__device__ __forceinline__ unsigned cvtpk_s(float lo, float hi) { typedef __bf16 bf16x2_t __attribute__((ext_vector_type(2))); f32x2 v = {lo, hi}; bf16x2_t b = __builtin_convertvector(v, bf16x2_t); return __builtin_bit_cast(unsigned, b); }

__device__ __forceinline__ void attn_unit(LAS unsigned char* lds, const bf16_t* P, const bf16_t* KI, const bf16_t* VI, bf16_t* mix, int b, int h, int qb, float lam, const float* subln) {
    const int tid = opaque_tid(), lane = tid & 63, r32 = lane & 31, hh = lane >> 5; const int wid = __builtin_amdgcn_readfirstlane(tid >> 6);
    const int comp = wid >> 2, rbk = wid & 3;
    const bf16_t* Pb = P + (size_t)b * RB * NPJ;
    const unsigned lds0 = (unsigned)(size_t)lds;
    const bf16_t* ksrc = KI + (size_t)((b * 4 + h) * 132) * 8192 + wid * 512 + lane * 8;
    const bf16_t* vsrc = VI + (size_t)((b * 4 + h) * 132) * 8192 + wid * 1024 + lane * 8;
    const unsigned kdst = lds0 + LDS_K + wid * KSTR, vdst = lds0 + LDS_V + (wid >> 1) * VDB + (wid & 1) * 2048;
#define DMA_K0(t, slot) glds16(ksrc + (size_t)(t) * 8192, (unsigned)__builtin_amdgcn_readfirstlane(kdst + (slot)))
#define DMA_K1(t, slot) glds16(ksrc + (size_t)(t) * 8192 + 4096, (unsigned)__builtin_amdgcn_readfirstlane(kdst + KCOMP + (slot)))
#define DMA_V0(t, slot) glds16(vsrc + (size_t)(t) * 8192, (unsigned)__builtin_amdgcn_readfirstlane(vdst + (slot)))
#define DMA_V1(t, slot) glds16(vsrc + (size_t)(t) * 8192 + 512, (unsigned)__builtin_amdgcn_readfirstlane(vdst + 1024 + (slot)))
    DMA_K0(0, 0); DMA_K1(0, 0); DMA_V0(0, 0); DMA_V1(0, 0); DMA_K0(1, KBUF); DMA_K1(1, KBUF); DMA_K0(2, 2 * KBUF); DMA_K1(2, 2 * KBUF);
    const int qrow = CTXL + qb * 128 + rbk * 32 + r32;
    const bf16_t* qp = Pb + (size_t)qrow * NPJ + h * 128 + comp * 64 + hh * 8;
    bf16x8 qf[4];
#pragma unroll
    for (int ks = 0; ks < 4; ++ks) qf[ks] = *(const bf16x8*)(qp + ks * 16);
    LAS unsigned char* kp0 = lds + LDS_K + comp * KCOMP + hh * KSTR + r32 * 16;
    LAS unsigned char* vp0 = lds + LDS_V + ((lane >> 4) & 1) * 32 + (lane & 3) * 8 + (4 * hh + ((lane & 15) >> 2)) * 64;
    int kpv = 3 * KBUF, kc = 0, kn = KBUF, kn2 = 2 * KBUF;
    int vp = 2 * VBUF, vc = 0, vn = VBUF;
#define ROT() do { const int a_ = kpv; kpv = kc; kc = kn; kn = kn2; kn2 = a_; const int b_ = vp; vp = vc; vc = vn; vn = b_; } while (0)
#define LDK(i) (*(const LAS bf16x8*)(kq + ((i) >> 1) * 2 * KSTR + ((i) & 1) * 512))
    f32x16 o[4]; o[0] = f32x16{}; o[1] = f32x16{}; o[2] = f32x16{}; o[3] = f32x16{};
    f32x16 negm, pA0, pA1, pB0, pB1;
    float lsum = 0.f;
    WAIT_BAR(6);
    {
        LAS unsigned char* kq = kp0 + kc;
        f32x16 s0 = {}, s1 = {};
#pragma unroll
        for (int i = 0; i < 8; i += 2) { s0 = MFMA32(LDK(i), qf[i >> 1], s0); s1 = MFMA32(LDK(i + 1), qf[i >> 1], s1); }
        float m = fmaxf(s0[0], s1[0]);
#pragma unroll
        for (int r = 1; r < 16; ++r) m = fmaxf(m, fmaxf(s0[r], s1[r]));
        m = fmaxf(m, __shfl_xor(m, 32));
#pragma unroll
        for (int r = 0; r < 16; ++r) { negm[r] = -m; pA0[r] = __builtin_amdgcn_exp2f(s0[r] - m); pA1[r] = __builtin_amdgcn_exp2f(s1[r] - m); }
        asm volatile("" : "+v"(negm));
        DMA_K0(3, kpv); DMA_K1(3, kpv); DMA_V0(1, vn); DMA_V1(1, vn);
        WAIT_BAR(4);
        ROT();
    }
    bf16x8 kfa, kfb;
    { LAS unsigned char* kq = kp0 + kc; kfa = LDK(0); kfb = LDK(1); }
    u32x4 pw0, pw1, pw2, pw3;
#define PKW(Pv, B) cvtpk_s(Pv[B], Pv[(B) + 1])
#define VLD(j) do { LAS unsigned char* a_ = vq + ((j) & 3) * VDB + ((j) >> 2) * 1024; vlo[j] = vtr(a_); vhi[j] = vtr(a_ + 512); } while (0)
#define VFR(j) (bf16x8){vlo[j][0], vlo[j][1], vlo[j][2], vlo[j][3], vhi[j][0], vhi[j][1], vhi[j][2], vhi[j][3]}
#define GAPA(i, Cx, CIN, A0, A1, A2, A3, W0, W1, PW) do { if ((i) + 2 < 8) kf[(i) + 2] = LDK((i) + 2); if ((i) >= 6) VLD((i) - 6); \
        Cx = MFMA32(kf[i], qf[(i) >> 1], CIN); sacc += A0; sacc += A1; sacc += A2; sacc += A3; PIN(sacc); W0; W1; PIN(PW); SBAR(); } while (0)
#define GAPB(j, PWv, X, B, EXTRA) do { if ((j) + 2 < 16) VLD((j) + 2); EXTRA; o[(j) & 3] = MFMA32(__builtin_bit_cast(bf16x8, PWv), VFR(j), o[(j) & 3]); \
        X[B] = __builtin_amdgcn_exp2f(X[B]); X[(B) + 1] = __builtin_amdgcn_exp2f(X[(B) + 1]); PIN(X); SBAR(); } while (0)
#define STEP(C0, C1, P0, P1, t, GK, GV, PRE) do { SBAR(); \
        LAS unsigned char* kq = kp0 + kc; LAS unsigned char* vq = vp0 + vp; LAS unsigned char* kqn = kp0 + kn; \
        bf16x8 kf[8]; s16x4 vlo[16], vhi[16]; \
        kf[0] = kfa; kf[1] = kfb; \
        float sacc = P0[0] + P0[1]; \
        GAPA(0, C0, negm, P0[2], P0[3], P0[4], P0[5],     pw0[0] = PKW(P0, 0),  pw0[1] = PKW(P0, 2),  pw0); \
        GAPA(1, C1, negm, P0[6], P0[7], P0[8], P0[9],     pw0[2] = PKW(P0, 4),  pw0[3] = PKW(P0, 6),  pw0); \
        GAPA(2, C0, C0,   P0[10], P0[11], P0[12], P0[13], pw1[0] = PKW(P0, 8),  pw1[1] = PKW(P0, 10), pw1); \
        GAPA(3, C1, C1,   P0[14], P0[15], P1[0], P1[1],   pw1[2] = PKW(P0, 12), pw1[3] = PKW(P0, 14), pw1); \
        GAPA(4, C0, C0,   P1[2], P1[3], P1[4], P1[5],     pw2[0] = PKW(P1, 0),  pw2[1] = PKW(P1, 2),  pw2); \
        GAPA(5, C1, C1,   P1[6], P1[7], P1[8], P1[9],     pw2[2] = PKW(P1, 4),  pw2[3] = PKW(P1, 6),  pw2); \
        GAPA(6, C0, C0,   P1[10], P1[11], P1[12], P1[13], pw3[0] = PKW(P1, 8),  pw3[1] = PKW(P1, 10), pw3); \
        GAPA(7, C1, C1,   P1[14], P1[15], 0.f, 0.f,       pw3[2] = PKW(P1, 12), pw3[3] = PKW(P1, 14), pw3); \
        lsum += sacc; \
        GAPB(0, pw0, C0, 0, if (GK) DMA_K0((t) + 3, kpv));  GAPB(1, pw0, C0, 2, if (GK) DMA_K1((t) + 3, kpv));  GAPB(2, pw0, C0, 4, if (GV) DMA_V0((t) + 1, vn));  GAPB(3, pw0, C0, 6, if (GV) DMA_V1((t) + 1, vn)); \
        GAPB(4, pw1, C0, 8, (void)0);  GAPB(5, pw1, C0, 10, (void)0); GAPB(6, pw1, C0, 12, (void)0); GAPB(7, pw1, C0, 14, (void)0); \
        GAPB(8, pw2, C1, 0, (void)0);  GAPB(9, pw2, C1, 2, (void)0);  GAPB(10, pw2, C1, 4, (void)0); GAPB(11, pw2, C1, 6, (void)0); \
        GAPB(12, pw3, C1, 8, (void)0); GAPB(13, pw3, C1, 10, (void)0); GAPB(14, pw3, C1, 12, if (PRE) kfa = *(const LAS bf16x8*)(kqn)); GAPB(15, pw3, C1, 14, if (PRE) kfb = *(const LAS bf16x8*)(kqn + 512)); \
    } while (0)
#pragma unroll 1
    for (int t = 1; t + 1 <= NT - 4; t += 2) {
        STEP(pB0, pB1, pA0, pA1, t, true, true, true);     WAIT_BAR(4); ROT();
        STEP(pA0, pA1, pB0, pB1, t + 1, true, true, true); WAIT_BAR(4); ROT();
    }
    STEP(pB0, pB1, pA0, pA1, NT - 3, false, true, true);   WAIT_BAR(2); ROT();
    STEP(pA0, pA1, pB0, pB1, NT - 2, false, true, true);   WAIT_BAR(2); ROT();
    STEP(pB0, pB1, pA0, pA1, NT - 1, false, false, false); WAIT_BAR(0); ROT();
    {
        float sacc = 0.f;
#pragma unroll
        for (int r = 0; r < 16; ++r) sacc += pB0[r] + pB1[r];
        lsum += sacc;
        pw0 = (u32x4){PKW(pB0, 0), PKW(pB0, 2), PKW(pB0, 4), PKW(pB0, 6)}; pw1 = (u32x4){PKW(pB0, 8), PKW(pB0, 10), PKW(pB0, 12), PKW(pB0, 14)};
        pw2 = (u32x4){PKW(pB1, 0), PKW(pB1, 2), PKW(pB1, 4), PKW(pB1, 6)}; pw3 = (u32x4){PKW(pB1, 8), PKW(pB1, 10), PKW(pB1, 12), PKW(pB1, 14)};
        LAS unsigned char* vq = vp0 + vp;
#pragma unroll
        for (int j = 0; j < 16; ++j) { LAS unsigned char* a_ = vq + (j & 3) * VDB + (j >> 2) * 1024; const s16x4 lo = vtr(a_), hi = vtr(a_ + 512);
            const bf16x8 vf = {lo[0], lo[1], lo[2], lo[3], hi[0], hi[1], hi[2], hi[3]};
            const u32x4 pws = (j >> 2) == 0 ? pw0 : (j >> 2) == 1 ? pw1 : (j >> 2) == 2 ? pw2 : pw3;
            o[j & 3] = MFMA32(__builtin_bit_cast(bf16x8, pws), vf, o[j & 3]); }
    }
    __syncthreads();
    lsum += __shfl_xor(lsum, 32);
    LAS float* wsf = (LAS float*)(lds + LDS_WS) + wid * 64;
    if (hh == 0) wsf[r32] = lsum;
    LDS_WAIT();
    LAS float* X = (LAS float*)lds + rbk * 4096;
    const float cmul = comp ? lam : 1.f;
#pragma unroll
    for (int r = 0; r < 16; ++r) { const float sc = cmul * __builtin_amdgcn_rcpf(wsf[crow(r, hh)]);
#pragma unroll
        for (int db = 0; db < 4; ++db) o[db][r] *= sc; }
    if (comp == 1) {
#pragma unroll
        for (int db = 0; db < 4; ++db)
#pragma unroll
            for (int r = 0; r < 16; ++r) X[(db * 16 + r) * 64 + lane] = o[db][r];
    }
    __syncthreads();
    if (comp == 0) {
        float sl[4];
#pragma unroll
        for (int db = 0; db < 4; ++db) sl[db] = subln[db * 32 + r32] * (1.f - LAMBDA_INIT);
        bf16_t* orow = mix + (size_t)(b * SEQ + qb * 128 + rbk * 32 + 4 * hh) * DM + h * 128 + r32;
#pragma unroll
        for (int r = 0; r < 16; ++r) {
            float ss = 0.f;
#pragma unroll
            for (int db = 0; db < 4; ++db) { o[db][r] -= X[(db * 16 + r) * 64 + lane]; ss += o[db][r] * o[db][r]; }
            ss = half_sum32(ss);
            const float rstd = __builtin_amdgcn_rsqf(ss * (1.f / 128.f) + NORM_EPS);
#pragma unroll
            for (int db = 0; db < 4; ++db) orow[(size_t)((r & 3) + 8 * (r >> 2)) * DM + db * 32] = (bf16_t)f2bf(o[db][r] * rstd * sl[db]);
        }
    }
    __syncthreads();
#undef DMA_K0
#undef DMA_K1
#undef DMA_V0
#undef DMA_V1
#undef ROT
#undef LDK
#undef PKW
#undef VLD
#undef VFR
#undef GAPA
#undef GAPB
#undef STEP
}
#undef SBAR
#undef PIN
#undef WAIT_BAR
}

struct SchedPlain {
    int nM, nN, nwg, G, c; const bf16_t* Bt; int K;
    __device__ bool next(int i, pg8::Unit& u) const {
        const long L = (long)i * G + c; if (L >= nwg) return false;
        int wgid = (int)L; { const int q = nwg / 8, r = nwg % 8, xcd = wgid % 8, off = wgid / 8; wgid = (xcd < r ? xcd * (q + 1) : r * (q + 1) + (xcd - r) * q) + off; }
        const int nig = 8 * nN, gid = wgid / nig, fm = gid * 8, gsz = (nM - fm) < 8 ? (nM - fm) : 8;
        u.pm = fm + ((wgid % nig) % gsz); u.pn = (wgid % nig) / gsz; u.arow0 = u.pm * 256; u.gadd = 0; u.gidx = nullptr; u.Bt = Bt + (size_t)u.pn * 256 * K; u.aux = 0; return true;
    }
};
struct EpiYbf16 {
    static constexpr bool PERM = true;
    bf16_t* O; int ldc;
    __device__ __forceinline__ void operator()(const f32x4 (&acc)[2][2][4][2], const pg8::Unit& u, int wr, int wc, int fr, int fq) const {
#pragma unroll
        for (int ai = 0; ai < 2; ++ai)
#pragma unroll
            for (int m = 0; m < 4; ++m) { bf16_t* rowp = O + (size_t)(u.pm * 256 + ai * 128 + wr * 64 + m * 16 + fr) * ldc + u.pn * 256 + wc * 32 + 8 * fq;
#pragma unroll
                for (int bj = 0; bj < 2; ++bj) { const f32x4 v0 = acc[ai][bj][m][0], v1 = acc[ai][bj][m][1];
                    u32x4 w; w.x = cvt_pk_bf16(v0[0], v0[1]); w.y = cvt_pk_bf16(v0[2], v0[3]); w.z = cvt_pk_bf16(v1[0], v1[1]); w.w = cvt_pk_bf16(v1[2], v1[3]);
                    *(u32x4*)(rowp + bj * 128) = w; } }
    }
};

__device__ __forceinline__ void p7_pre(Frame& F, const Args& a) {
    const int tid_ = opaque_tid();
    LAS float* par = (LAS float*)F.lds;
    LAS float* wrT = (LAS float*)(F.lds + 24576);
    const float* mod = (const float*)(a.ws + WS_MOD);
    for (int i = tid_; i < 2048; i += 512) { const int b = i >> 10, c = i & 1023;
        par[b * 3072 + c] = mod[b * 6144 + 2048 + c] * a.n_post_mix[c]; par[b * 3072 + 1024 + c] = a.n_pre_ffn[c] * (1.f + mod[b * 6144 + 4096 + c]); par[b * 3072 + 2048 + c] = mod[b * 6144 + 3072 + c]; }
    for (int i = tid_; i < 16384; i += 512) { const int c = i >> 4, e = i & 15; wrT[e * 1024 + c] = a.w_router[i]; }
}
__device__ __forceinline__ void p7_rowpass(Frame& F, const Args& a) {
    const int tid_ = opaque_tid(), lane_ = tid_ & 63; const int wave_ = __builtin_amdgcn_readfirstlane(tid_ >> 6);
    LAS float* par = (LAS float*)F.lds; LAS float* wrT = (LAS float*)(F.lds + 24576);
    __syncthreads();
    const bf16_t* ylat = (const bf16_t*)(a.ws + WS_YLAT); unsigned char* h2 = a.ws + WS_H2; float* aff = (float*)(a.ws + WS_AFF);
    const int gw = F.vcu * NWAVES + wave_, NGW = F.G * NWAVES;
    u32x2 ywn[2][4]; f32x4 xvn[2][4];
#define P7_LOAD(m0_) do { const bool v1_ = (m0_) + NGW < ML; const int mm_[2] = {(m0_), v1_ ? (m0_) + NGW : (m0_)}; \
        _Pragma("unroll") for (int u = 0; u < 2; ++u) { const GAS u32x2* yr = (const GAS u32x2*)(ylat + (size_t)mm_[u] * DM) + lane_; const GAS f32x4* xr = (const GAS f32x4*)(a.x + (size_t)mm_[u] * DM) + lane_; \
            _Pragma("unroll") for (int j = 0; j < 4; ++j) { ywn[u][j] = yr[64 * j]; xvn[u][j] = xr[64 * j]; } } } while (0)
    if (gw < ML) P7_LOAD(gw);
    for (int m0 = gw; m0 < ML; m0 += 2 * NGW) {
        const bool v1 = m0 + NGW < ML; const int mm[2] = {m0, v1 ? m0 + NGW : m0};
        f32x4 yv[2][4], xv[2][4]; float ss[2] = {0.f, 0.f};
#pragma unroll
        for (int u = 0; u < 2; ++u)
#pragma unroll
            for (int j = 0; j < 4; ++j) { const u32x2 w = ywn[u][j]; yv[u][j] = (f32x4){__builtin_bit_cast(float, w.x << 16), __builtin_bit_cast(float, w.x & 0xffff0000u), __builtin_bit_cast(float, w.y << 16), __builtin_bit_cast(float, w.y & 0xffff0000u)}; xv[u][j] = xvn[u][j]; }
        if (m0 + 2 * NGW < ML) P7_LOAD(m0 + 2 * NGW);
#pragma unroll
        for (int u = 0; u < 2; ++u)
#pragma unroll
            for (int j = 0; j < 4; ++j) ss[u] += (yv[u][j].x * yv[u][j].x + yv[u][j].y * yv[u][j].y) + (yv[u][j].z * yv[u][j].z + yv[u][j].w * yv[u][j].w);
        ss[0] = wave_sum(ss[0]); ss[1] = wave_sum(ss[1]);
        float ss2[2] = {0.f, 0.f};
#pragma unroll
        for (int u = 0; u < 2; ++u) { const int b = mm[u] >> 13; const float rstd = __builtin_amdgcn_rsqf(ss[u] * (1.f / DM) + NORM_EPS);
            GAS unsigned long long* orow = (GAS unsigned long long*)((bf16_t*)(a.ws + WS_X1B) + (size_t)mm[u] * DM) + lane_;
#pragma unroll
            for (int j = 0; j < 4; ++j) { const int c = 4 * lane_ + 256 * j; const f32x4 a1 = *(const LAS f32x4*)(par + b * 3072 + c);
                xv[u][j] = xv[u][j] + a1 * (yv[u][j] * rstd); if (u == 0 || v1) orow[64 * j] = (unsigned long long)cvt_pk_bf16(xv[u][j].x, xv[u][j].y) | ((unsigned long long)cvt_pk_bf16(xv[u][j].z, xv[u][j].w) << 32);
                ss2[u] += (xv[u][j].x * xv[u][j].x + xv[u][j].y * xv[u][j].y) + (xv[u][j].z * xv[u][j].z + xv[u][j].w * xv[u][j].w); } }
        ss2[0] = wave_sum(ss2[0]); ss2[1] = wave_sum(ss2[1]);
#pragma unroll
        for (int u = 0; u < 2; ++u) { if (u == 1 && !v1) break;
            const int m = mm[u], b = m >> 13, t = m & 8191;
            const float rstd2 = __builtin_amdgcn_rsqf(ss2[u] * (1.f / DM) + NORM_EPS);
            GAS unsigned* o8 = (GAS unsigned*)(h2 + (size_t)m * DM) + lane_;
            f32x2 lg2[16];
#pragma unroll
            for (int e = 0; e < 16; ++e) lg2[e] = (f32x2){0.f, 0.f};
#pragma unroll
            for (int j = 0; j < 4; ++j) { const int c = 4 * lane_ + 256 * j; const f32x4 a2 = *(const LAS f32x4*)(par + b * 3072 + 1024 + c), a3 = *(const LAS f32x4*)(par + b * 3072 + 2048 + c);
                const f32x4 hv = xv[u][j] * rstd2 * a2 + a3;
                { float h0 = hv.x, h1 = hv.y, h2_ = hv.z, h3 = hv.w; asm volatile("" : "+v"(h0), "+v"(h1), "+v"(h2_), "+v"(h3)); o8[64 * j] = cvt4_fp8_sat(h0, h1, h2_, h3); }
                const f32x2 hlo = {hv.x, hv.y}, hhi = {hv.z, hv.w};
#pragma unroll
                for (int e = 0; e < 16; ++e) { const f32x4 w = *(const LAS f32x4*)(wrT + e * 1024 + c); lg2[e] = __builtin_elementwise_fma(hlo, (f32x2){w.x, w.y}, lg2[e]); lg2[e] = __builtin_elementwise_fma(hhi, (f32x2){w.z, w.w}, lg2[e]); } }
            float lg[16];
#pragma unroll
            for (int e = 0; e < 16; ++e) lg[e] = lg2[e].x + lg2[e].y;
            const float lgt = reduce16(lg, lane_);
            const float mx = row_max16(lgt), pe = __expf(lgt - mx), den = row_sum16(pe);
            if (lane_ < 16) aff[(size_t)(b * 16 + lane_) * SEQ + t] = pe / den;
            __builtin_amdgcn_sched_barrier(0); }
    }
#undef P7_LOAD
    __syncthreads();
}


__device__ __forceinline__ void topk_unit(LAS unsigned char* lds, const float* aff, int* sel_idx, float* sel_gate, short* slot_map, int be) {
    const int tid = opaque_tid(), lane = tid & 63; const int wid = __builtin_amdgcn_readfirstlane(tid >> 6);
    const int b = be >> 4, e = be & 15;
    LAS unsigned* ctl = (LAS unsigned*)(lds + 1024);
    const float* ap = aff + (size_t)be * SEQ + tid * 16;
    unsigned key[16];
#pragma unroll
    for (int j = 0; j < 4; ++j) { const u32x4 v = *(const u32x4*)(ap + 4 * j); key[4 * j] = v.x; key[4 * j + 1] = v.y; key[4 * j + 2] = v.z; key[4 * j + 3] = v.w; }
    unsigned prefix = 0u;
#pragma unroll 1
    for (int bit = 30; bit >= 0; --bit) {
        const unsigned cand = prefix | (1u << bit);
        unsigned c = 0u;
#pragma unroll
        for (int i = 0; i < 16; ++i) c += key[i] >= cand ? 1u : 0u;
        c = wave_sum_u(c);
        LAS unsigned* bank = ctl + (bit & 1) * 8;
        if (lane == 0) bank[wid] = c;
        __syncthreads();
        unsigned tot = 0u;
#pragma unroll
        for (int w = 0; w < 8; ++w) tot += bank[w];
        if (tot >= (unsigned)CAP) prefix = cand;
    }
    unsigned need;
    {
        unsigned c = 0u;
#pragma unroll
        for (int i = 0; i < 16; ++i) c += key[i] > prefix ? 1u : 0u;
        c = wave_sum_u(c);
        __syncthreads();
        if (lane == 0) ctl[wid] = c;
        __syncthreads();
        unsigned tot = 0u;
#pragma unroll
        for (int w = 0; w < 8; ++w) tot += ctl[w];
        need = (unsigned)CAP - tot;
        __syncthreads();
    }
    const unsigned T = prefix;
    unsigned cg = 0u, ce = 0u;
#pragma unroll
    for (int i = 0; i < 16; ++i) { cg += key[i] > T ? 1u : 0u; ce += key[i] == T ? 1u : 0u; }
    unsigned pk = cg | (ce << 16), inc = pk;
#pragma unroll
    for (int o = 1; o < 64; o <<= 1) { const unsigned n = __shfl_up(inc, o); if (lane >= o) inc += n; }
    if (lane == 63) ctl[16 + wid] = inc;
    __syncthreads();
    unsigned wbase = 0u;
#pragma unroll
    for (int w = 0; w < 8; ++w) if (w < wid) wbase += ctl[16 + w];
    const unsigned excl = wbase + inc - pk;
    unsigned sg = excl & 0xffffu, se = excl >> 16;
    const unsigned total_gt = CAP - need;
    int* si = sel_idx + (size_t)be * CAP; float* sgp = sel_gate + (size_t)be * CAP; short* sm = slot_map + ((size_t)b * SEQ + tid * 16) * 16 + e;
#pragma unroll
    for (int i = 0; i < 16; ++i) {
        int slot = -1;
        if (key[i] > T) { slot = (int)sg; ++sg; }
        else if (key[i] == T) { if (se < need) slot = (int)(total_gt + se); ++se; }
        if (slot >= 0) { si[slot] = tid * 16 + i; sgp[slot] = __builtin_bit_cast(float, key[i]); }
        sm[i * 16] = (short)slot;
    }
    __syncthreads();
}

struct SchedMoe1 {
    int c; const bf16_t* Wgu; const int* sel_idx;
    __device__ bool next(int i, pg8::Unit& u) const {
        if (i >= 4) return false;
        const int x = c & 7, j = c >> 3, ui = i * 32 + j, e = x + 8 * (ui >> 6), rem = ui & 63, b = rem >> 5, mt = (rem >> 3) & 3, pn = rem & 7;
        u.pm = (b * 16 + e) * 4 + mt; u.pn = pn; u.arow0 = 0; u.gadd = b * SEQ; u.gidx = sel_idx + (size_t)(b * 16 + e) * CAP + mt * 256;
        u.Bt = (const bf16_t*)((const unsigned char*)Wgu + (size_t)e * 2097152 + (size_t)pn * 256 * 1024); u.aux = 0; return true;
    }
};
struct EpiSwiglu {
    static constexpr bool PERM = true;
    unsigned char* H;
    __device__ __forceinline__ void operator()(const f32x4 (&acc)[2][2][4][2], const pg8::Unit& u, int wr, int wc, int fr, int fq) const {
#pragma unroll
        for (int ai = 0; ai < 2; ++ai)
#pragma unroll
            for (int m = 0; m < 4; ++m) { unsigned char* rowp = H + (size_t)(u.pm * 256 + ai * 128 + wr * 64 + m * 16 + fr) * FFD + u.pn * 128 + wc * 32 + 8 * fq;
                float hv[8];
#pragma unroll
                for (int n = 0; n < 2; ++n)
#pragma unroll
                    for (int i = 0; i < 4; ++i) { const float ag = acc[ai][0][m][n][i], au = acc[ai][1][m][n][i];
                        hv[4 * n + i] = (ag * au) * (__builtin_amdgcn_rcpf(1.f + __builtin_amdgcn_exp2f(ag * (-W8_INV * 1.4426950408889634f))) * (W8_INV * W8_INV)); }
                u32x2 w; w.x = cvt4_fp8_sat(hv[0], hv[1], hv[2], hv[3]); w.y = cvt4_fp8_sat(hv[4], hv[5], hv[6], hv[7]);
                *(u32x2*)rowp = w; }
    }
};
struct SchedMoe2 {
    int c; const bf16_t* Wd;
    __device__ bool next(int i, pg8::Unit& u) const {
        if (i >= 2) return false;
        const int x = c & 7, j = c >> 3, e = x + 8 * i, b = j >> 4, mt = (j >> 2) & 3, pn = j & 3;
        u.pm = (b * 16 + e) * 4 + mt; u.pn = pn; u.arow0 = u.pm * 256; u.gadd = 0; u.gidx = nullptr;
        u.Bt = (const bf16_t*)((const unsigned char*)Wd + (size_t)e * 1048576 + (size_t)pn * 256 * 1024); u.aux = 0; return true;
    }
};
struct EpiGateBf16 {
    static constexpr bool PERM = true;
    bf16_t* Y; const float* gate;
    __device__ __forceinline__ void operator()(const f32x4 (&acc)[2][2][4][2], const pg8::Unit& u, int wr, int wc, int fr, int fq) const {
#pragma unroll
        for (int ai = 0; ai < 2; ++ai)
#pragma unroll
            for (int m = 0; m < 4; ++m) { const int row = u.pm * 256 + ai * 128 + wr * 64 + m * 16 + fr; const float gt = gate[row];
                bf16_t* rowp = Y + (size_t)row * DM + u.pn * 256 + wc * 32 + 8 * fq;
#pragma unroll
                for (int bj = 0; bj < 2; ++bj) { const f32x4 v0 = acc[ai][bj][m][0] * (gt * W8_INV), v1 = acc[ai][bj][m][1] * (gt * W8_INV);
                    u32x4 w; w.x = cvt_pk_bf16(v0[0], v0[1]); w.y = cvt_pk_bf16(v0[2], v0[3]); w.z = cvt_pk_bf16(v1[0], v1[1]); w.w = cvt_pk_bf16(v1[2], v1[3]);
                    *(u32x4*)(rowp + bj * 128) = w; } }
    }
};

__device__ __forceinline__ void p11_pre(Frame& F, const Args& a) {
    const int tid = opaque_tid();
    LAS float* par = (LAS float*)F.lds;
    const float* mod = (const float*)(a.ws + WS_MOD);
    for (int i = tid; i < 2048; i += 512) { const int b = i >> 10, c = i & 1023; par[i] = mod[b * 6144 + 5120 + c] * a.n_post_ffn[c]; }
}
__device__ __forceinline__ void p11_combine(Frame& F, const Args& a) {
    const int tid = opaque_tid(), lane = tid & 63; const int wave = __builtin_amdgcn_readfirstlane(tid >> 6);
    LAS float* par = (LAS float*)F.lds;
    __syncthreads();
    const bf16_t* ye = (const bf16_t*)(a.ws + WS_YE); const short* slot_map = (const short*)(a.ws + WS_SLOT);
    const int gw = F.vcu * NWAVES + wave, NGW = F.G * NWAVES;
    for (int m0 = gw; m0 < ML; m0 += 2 * NGW) {
        const bool v1 = m0 + NGW < ML; const int mm[2] = {m0, v1 ? m0 + NGW : m0};
        f32x4 f[2][4]; f32x4 xo[2][4];
#pragma unroll
        for (int u = 0; u < 2; ++u) { const int m = mm[u], b = m >> 13;
            const u32x4 s0 = *(const u32x4*)(slot_map + (size_t)m * 16), s1 = *(const u32x4*)(slot_map + (size_t)m * 16 + 8);
            const unsigned sw[8] = {s0.x, s0.y, s0.z, s0.w, s1.x, s1.y, s1.z, s1.w};
            const GAS u32x2* xr = (const GAS u32x2*)((const bf16_t*)(a.ws + WS_X1B) + (size_t)m * DM) + lane;
#pragma unroll
            for (int j = 0; j < 4; ++j) { f[u][j] = f32x4{}; const u32x2 w = xr[64 * j]; xo[u][j] = (f32x4){__builtin_bit_cast(float, w.x << 16), __builtin_bit_cast(float, w.x & 0xffff0000u), __builtin_bit_cast(float, w.y << 16), __builtin_bit_cast(float, w.y & 0xffff0000u)}; }
#pragma unroll
            for (int e = 0; e < 16; ++e) {
                const int slot = (int)(short)((sw[e >> 1] >> ((e & 1) * 16)) & 0xffffu);
                if (__builtin_amdgcn_readfirstlane(slot) >= 0) {
                    const GAS u32x2* yr = (const GAS u32x2*)(ye + ((size_t)(b * 16 + e) * CAP + slot) * DM) + lane;
#pragma unroll
                    for (int j = 0; j < 4; ++j) { const u32x2 w = yr[64 * j];
                        f[u][j].x += __builtin_bit_cast(float, w.x << 16); f[u][j].y += __builtin_bit_cast(float, w.x & 0xffff0000u); f[u][j].z += __builtin_bit_cast(float, w.y << 16); f[u][j].w += __builtin_bit_cast(float, w.y & 0xffff0000u); }
                }
            } }
        float ss[2] = {0.f, 0.f};
#pragma unroll
        for (int u = 0; u < 2; ++u)
#pragma unroll
            for (int j = 0; j < 4; ++j) ss[u] += (f[u][j].x * f[u][j].x + f[u][j].y * f[u][j].y) + (f[u][j].z * f[u][j].z + f[u][j].w * f[u][j].w);
        ss[0] = wave_sum(ss[0]); ss[1] = wave_sum(ss[1]);
#pragma unroll
        for (int u = 0; u < 2; ++u) { if (u == 1 && !v1) break;
            const int m = mm[u], b = m >> 13; const float rstd = __builtin_amdgcn_rsqf(ss[u] * (1.f / DM) + NORM_EPS);
            GAS f32x4* orow = (GAS f32x4*)(a.out + (size_t)m * DM) + lane;
#pragma unroll
            for (int j = 0; j < 4; ++j) { const int c = 4 * lane + 256 * j; const f32x4 p = *(const LAS f32x4*)(par + b * 1024 + c); orow[64 * j] = xo[u][j] + p * (f[u][j] * rstd); } }
    }
}


namespace ctxp {
constexpr int AST = 272;
constexpr int L_A = 0, L_B = 64 * AST, L_RED = 2 * 64 * AST;
__device__ __forceinline__ void tile(LAS unsigned char* lds, const bf16_t* hn, const bf16_t* wt, int t, bf16_t* P, bf16_t* KI, bf16_t* VI, const float* hglb) {
    const int tid = opaque_tid(), lane = tid & 63, hh = lane >> 5, r32 = lane & 31; const int wid = __builtin_amdgcn_readfirstlane(tid >> 6);
    const int rbk = t / 40, cb = t % 40, b = rbk >> 2;
    const int row0 = b * RB + (rbk & 3) * 64;
    const int col0 = 512 + cb * 64;
    const int lr = tid >> 4, lp = tid & 15;
    const GAS bf16_t* ag = (const GAS bf16_t*)(hn + (size_t)(row0 + lr) * DM + lp * 8);
    const GAS bf16_t* bg = (const GAS bf16_t*)(wt + (size_t)(col0 + lr) * DM + lp * 8);
    u32x4 ra0 = *(const GAS u32x4*)ag, ra1 = *(const GAS u32x4*)(ag + (size_t)32 * DM), rb0 = *(const GAS u32x4*)bg, rb1 = *(const GAS u32x4*)(bg + (size_t)32 * DM);
    const int rb2 = wid & 1, cb2 = (wid >> 1) & 1, kh = wid >> 2;
    f32x16 acc = {};
#pragma unroll 1
    for (int kc = 0; kc < 8; ++kc) {
        __syncthreads();
        *(LAS u32x4*)(lds + L_A + lr * AST + lp * 16) = ra0; *(LAS u32x4*)(lds + L_A + (lr + 32) * AST + lp * 16) = ra1;
        *(LAS u32x4*)(lds + L_B + lr * AST + lp * 16) = rb0; *(LAS u32x4*)(lds + L_B + (lr + 32) * AST + lp * 16) = rb1;
        if (kc < 7) { ra0 = *(const GAS u32x4*)(ag + (kc + 1) * 128); ra1 = *(const GAS u32x4*)(ag + (size_t)32 * DM + (kc + 1) * 128); rb0 = *(const GAS u32x4*)(bg + (kc + 1) * 128); rb1 = *(const GAS u32x4*)(bg + (size_t)32 * DM + (kc + 1) * 128); }
        __syncthreads();
#pragma unroll
        for (int ks = 0; ks < 4; ++ks) { const int ko = (kh * 64 + ks * 16 + hh * 8) * 2;
            const bf16x8 af = *(const LAS bf16x8*)(lds + L_A + (32 * rb2 + r32) * AST + ko), bf = *(const LAS bf16x8*)(lds + L_B + (32 * cb2 + r32) * AST + ko);
            acc = MFMA32(af, bf, acc); }
    }
    __syncthreads();
    LAS float* red = (LAS float*)(lds + L_RED) + (wid & 3) * 1024;
    if (kh == 1) {
#pragma unroll
        for (int r = 0; r < 16; ++r) red[r * 64 + lane] = acc[r]; }
    __syncthreads();
    if (kh == 0) {
        const int cs_ = col0 + 32 * cb2 + r32;
        const int c = cs_ < 1024 ? ((cs_ & ~31) + ((cs_ >> 2) & 1) * 16 + ((cs_ >> 3) & 3) * 4 + (cs_ & 3)) : cs_;
        const int region = c >> 9;
        float lbv = 0.f;
        if (region == 3 || region == 4) { const int d = region - 3, cc = c & 511; lbv = 1.f / (1.f + __expf(hglb[1024 + d * 512 + cc] - hglb[d * 512 + cc])); }
#pragma unroll
        for (int r = 0; r < 16; ++r) {
            float v = acc[r] + red[r * 64 + lane];
            const int rr = (rbk & 3) * 64 + 32 * rb2 + att::crow(r, hh);
            if (region == 3 || region == 4) { const float sg = __builtin_amdgcn_rcpf(1.f + __expf(-v)); v = __builtin_amdgcn_logf(lbv + (1.f - lbv) * sg); }
            const bf16_t o = (bf16_t)cvt_pk_bf16(v, v);
            if (region == 1) { const int cK = c - 512, h = cK >> 7, comp = (cK >> 6) & 1, d = cK & 63;
                KI[((size_t)((b * 4 + h) * 132 + (rr >> 6))) * 8192 + (comp * 8 + (d >> 3)) * 512 + (rr & 63) * 8 + (d & 7)] = o; }
            else if (region == 2) { const int cV = c - 1024, h = cV >> 7, dv = cV & 127;
                VI[((size_t)((b * 4 + h) * 132 + (rr >> 6))) * 8192 + (dv >> 5) * 2048 + (rr & 63) * 32 + (dv & 31)] = o; }
            else P[(size_t)(b * RB + rr) * NPJ + (c - 1024)] = o;
        }
    }
    __syncthreads();
}
}

__global__ void __launch_bounds__(NWAVES * 64, 2) fwd_kernel(Args args) {
    extern __shared__ __attribute__((aligned(16))) unsigned char lds[];
    Frame F;
    F.lds = (LAS unsigned char*)lds;
    F.MISC = (volatile LAS unsigned*)(F.lds + MISC_OFF);
    F.tid = threadIdx.x; F.lane = F.tid & 63; F.wave = __builtin_amdgcn_readfirstlane(F.tid >> 6);
    F.G = gridDim.x; { const int bx = blockIdx.x; F.vcu = (F.G % 8 == 0) ? (bx % 8) * (F.G / 8) + bx / 8 : bx; }
    unsigned char* ws = args.ws;
    F.ctl = (gu32*)(ws + WS_CTL);
    for (int u = F.tid; u < (LDS_BYTES - LDSCTL_OFF) / 4; u += NWAVES * 64) ((LAS unsigned*)(F.lds + LDSCTL_OFF))[u] = 0u;
    __syncthreads();
    XcdBarrier bar = xcd_barrier_post((unsigned*)(F.ctl + CW_BAR), F.MISC + 8);
    const int lo = args.ph_lo, hi = args.ph_hi;
#define IN(k) (lo <= (k) && (k) < hi)
#define GRID_BAR() xcd_barrier(bar)

    if (IN(0)) { p0_prologue(F, args); GRID_BAR(); }
    if (IN(1)) { p1_norm(F, args); GRID_BAR(); }
    if (IN(2)) {
        for (int t = (int)blockIdx.x; t < 320; t += F.G) ctxp::tile(F.lds, (const bf16_t*)(ws + WS_HN), (const bf16_t*)(ws + WS_WIN), t, (bf16_t*)(ws + WS_PROJ), (bf16_t*)(ws + WS_KIMG), (bf16_t*)(ws + WS_VIMG), args.hglb);
        SchedInProj S; S.nM = ML / 256; S.nN = NIN / 256; S.nwg = S.nM * S.nN; S.G = F.G; S.c = (int)blockIdx.x; S.Bt = (const bf16_t*)(ws + WS_WIN); S.K = DM;
        EpiInProj E{(bf16_t*)(ws + WS_PROJ), (bf16_t*)(ws + WS_KIMG), (bf16_t*)(ws + WS_VIMG), (const f32x2*)(ws + WS_ROPE), args.hglb};
        pg8::gemm_phase<EpiInProj, SchedInProj, true>(F.lds, (const bf16_t*)(ws + WS_HN), DM, S, E);
        GRID_BAR();
    }
    if (IN(4)) {
        hg::h1_phase(F.lds, (const bf16_t*)(ws + WS_PROJ), (float*)(ws + WS_HGU), (float*)(ws + WS_HGD), F.vcu, F.G);
        GRID_BAR();
        hg::scan_phase((float*)(ws + WS_HGU), (const float*)(ws + WS_HGD), (int)(blockIdx.x * 512 + opaque_tid()));
        GRID_BAR();
    }
    if (IN(3)) {
        float lam;
        { float d1 = 0.f, d2 = 0.f;
          for (int i = 0; i < 64; ++i) { d1 += args.lq1[i] * args.lk1[i]; d2 += args.lq2[i] * args.lk2[i]; }
          lam = __expf(d1) - __expf(d2) + LAMBDA_INIT; }
        const int bh = blockIdx.x & 7, sub = blockIdx.x >> 3;
        for (int i = 0; i < 2; ++i) att2::attn_unit(F.lds, (const bf16_t*)(ws + WS_PROJ), (const bf16_t*)(ws + WS_KIMG), (const bf16_t*)(ws + WS_VIMG), (bf16_t*)args.out, bh >> 2, bh & 3, sub + 32 * i, lam, args.da_subln);
    }
    if (IN(5)) {
        for (int u = F.vcu; u < 256; u += F.G) hg::h3_unit(F.lds, (const bf16_t*)(ws + WS_PROJ), (const float*)(ws + WS_HGU), (bf16_t*)args.out, args.out + 8388608, args.hg_norm, u);
        GRID_BAR();
    }
    if (IN(6)) {
        SchedPlain S; S.nM = ML / 256; S.nN = DM / 256; S.nwg = S.nM * S.nN; S.G = F.G; S.c = (int)blockIdx.x; S.Bt = (const bf16_t*)(ws + WS_WOUT); S.K = DM;
        EpiYbf16 E{(bf16_t*)(ws + WS_YLAT), DM};
        pg8::gemm_phase<EpiYbf16, SchedPlain, false>(F.lds, (const bf16_t*)args.out, DM, S, E);
    }
    if (IN(7)) p7_pre(F, args);
    if (IN(6)) GRID_BAR();
    if (IN(7)) { p7_rowpass(F, args); GRID_BAR(); }
    if (IN(8)) {
        if (blockIdx.x < 32) topk_unit(F.lds, (const float*)(ws + WS_AFF), (int*)(ws + WS_SELIDX), (float*)(ws + WS_SELGATE), (short*)(ws + WS_SLOT), (int)blockIdx.x);
        else { const int t8 = opaque_tid(); convert_items(F, args, P0_ITEMS_EARLY, P0_ITEMS_ALL, ((int)blockIdx.x - 32) * NWAVES + (t8 >> 6), (F.G - 32) * NWAVES, __builtin_amdgcn_readfirstlane(t8 >> 6), t8 & 63); }
        GRID_BAR();
    }
    if (IN(9)) {
        SchedMoe1 S{(int)blockIdx.x, (const bf16_t*)(ws + WS_WGU), (const int*)(ws + WS_SELIDX)};
        EpiSwiglu E{ws + WS_HB};
        pg8::gemm_phase<EpiSwiglu, SchedMoe1, true, true>(F.lds, (const bf16_t*)(ws + WS_H2), DM, S, E);
        GRID_BAR();
    }
    if (IN(10)) {
        SchedMoe2 S{(int)blockIdx.x, (const bf16_t*)(ws + WS_WD)};
        EpiGateBf16 E{(bf16_t*)(ws + WS_YE), (const float*)(ws + WS_SELGATE)};
        pg8::gemm_phase<EpiGateBf16, SchedMoe2, true, true>(F.lds, (const bf16_t*)(ws + WS_HB), FFD, S, E);
    }
    if (IN(11)) p11_pre(F, args);
    if (IN(10)) GRID_BAR();
    if (IN(11)) p11_combine(F, args);
#undef IN
#undef GRID_BAR
}

extern "C" void kernel_launch(void* const* d_in, const int* in_sizes, int n_in, void* d_out, int out_size, void* d_ws, size_t ws_size, hipStream_t stream) {
    static int grid = 0;
    if (grid == 0) {
        if (n_in != 23 || in_sizes[0] != ML * DM || out_size != ML * DM || ws_size < WS_END) { fprintf(stderr, "kernel_launch: unexpected shapes (n_in %d, in0 %d, out %d, ws %zu)\n", n_in, n_in > 0 ? in_sizes[0] : -1, out_size, ws_size); grid = -1; return; }
        int dev = 0, cus = 0, per_cu = 0;
        if (hipGetDevice(&dev) != hipSuccess || hipDeviceGetAttribute(&cus, hipDeviceAttributeMultiprocessorCount, dev) != hipSuccess) { grid = -1; return; }
        if (hipFuncSetAttribute((const void*)fwd_kernel, hipFuncAttributeMaxDynamicSharedMemorySize, LDS_BYTES) != hipSuccess) { fprintf(stderr, "kernel_launch: hipFuncSetAttribute failed\n"); grid = -1; return; }
        if (hipOccupancyMaxActiveBlocksPerMultiprocessor(&per_cu, (const void*)fwd_kernel, NWAVES * 64, LDS_BYTES) != hipSuccess || per_cu < 1) { fprintf(stderr, "kernel_launch: occupancy query says %d blocks per CU\n", per_cu); (void)hipGetLastError(); grid = -1; return; }
        grid = cus;
    }
    if (grid < 0) return;
    if (hipMemsetAsync((char*)d_ws + WS_CTL, 0, CTL_ZERO_BYTES, stream) != hipSuccess) return;
    Args a{};
    const float** p = (const float**)&a;
    for (int i = 0; i < 23; ++i) p[i] = (const float*)d_in[i];
    a.out = (float*)d_out; a.ws = (unsigned char*)d_ws; a.ph_lo = 0; a.ph_hi = 12;
#if PROBE_PH >= 0
    a.ph_lo = 0; a.ph_hi = PROBE_PH + 1; hipLaunchKernelGGL(fwd_kernel, dim3(grid), dim3(NWAVES * 64), LDS_BYTES, stream, a);
    (void)hipMemsetAsync((char*)d_ws + WS_CTL, 0, CTL_ZERO_BYTES, stream);
    a.ph_lo = PROBE_PH; a.ph_hi = PROBE_PH + 1; hipLaunchKernelGGL(fwd_kernel, dim3(grid), dim3(NWAVES * 64), LDS_BYTES, stream, a);
    (void)hipMemsetAsync((char*)d_ws + WS_CTL, 0, CTL_ZERO_BYTES, stream);
    a.ph_lo = PROBE_PH + 1; a.ph_hi = 12; hipLaunchKernelGGL(fwd_kernel, dim3(grid), dim3(NWAVES * 64), LDS_BYTES, stream, a);
#else
    hipLaunchKernelGGL(fwd_kernel, dim3(grid), dim3(NWAVES * 64), LDS_BYTES, stream, a);
#endif
}
```

```cpp
#include <hip/hip_runtime.h>
#include <cstdio>
#include <cstdint>

#define LAS __attribute__((address_space(3)))
#define GAS __attribute__((address_space(1)))
typedef unsigned short bf16_t;
typedef short bf16x8 __attribute__((ext_vector_type(8)));
typedef short s16x4 __attribute__((ext_vector_type(4)));
typedef float f32x4 __attribute__((ext_vector_type(4)));
typedef float f32x2 __attribute__((ext_vector_type(2)));
typedef float f32x16 __attribute__((ext_vector_type(16)));
typedef unsigned u32x4 __attribute__((ext_vector_type(4)));
typedef unsigned u32x2 __attribute__((ext_vector_type(2)));
typedef unsigned u32x16 __attribute__((ext_vector_type(16)));
typedef GAS unsigned gu32;

constexpr int BATCH = 2, SEQ = 8192, CTXL = 256, DM = 1024, NIN = 4096, NPJ = 3072;
constexpr int RB = CTXL + SEQ;
constexpr int MR = BATCH * RB;
constexpr int ML = BATCH * SEQ;
constexpr int NEXP = 16, CAP = 1024, FFD = 1024;
constexpr float NORM_EPS = 1e-6f;
constexpr float QSCALE = 0.125f * 1.4426950408889634f;
constexpr float LAMBDA_INIT = 0.2f;

constexpr size_t MiB = 1u << 20;
constexpr size_t WS_CTL = 0, CTL_ZERO_BYTES = 64 * 1024;
constexpr size_t WS_MOD = 1 * MiB;
constexpr size_t WS_ROPE = 1 * MiB + 128 * 1024;
constexpr size_t WS_AFF = 2 * MiB;
constexpr size_t WS_SELIDX = 3 * MiB;
constexpr size_t WS_SELGATE = 3 * MiB + 128 * 1024;
constexpr size_t WS_SLOT = 3 * MiB + 512 * 1024;
constexpr size_t WS_HGD = 4 * MiB;
constexpr size_t WS_WIN = 5 * MiB;
constexpr size_t WS_WOUT = 13 * MiB;
constexpr size_t WS_WGU = 15 * MiB;
constexpr size_t WS_X1B = 47 * MiB;
constexpr size_t WS_WD = 79 * MiB;
constexpr size_t WS_PROJ = 111 * MiB;
constexpr size_t WS_KIMG = 210 * MiB;
constexpr size_t WS_VIMG = 210 * MiB + 8650752;
constexpr size_t WS_HN8 = 210 * MiB + 17301504;
constexpr size_t WS_WIN8 = 95 * MiB;
constexpr size_t WS_HN = 243 * MiB;
constexpr size_t WS_END = 276 * MiB;
constexpr size_t WS_YLAT = WS_PROJ;
constexpr size_t WS_HB = WS_PROJ;
constexpr size_t WS_YE = WS_PROJ + 64 * MiB;
constexpr size_t WS_HGU = WS_HN;
constexpr size_t WS_H2 = WS_HN;
constexpr int CW_BAR = 4096;
#ifndef PROBE_PH
#define PROBE_PH -1
#endif

constexpr int RING_BYTES = 143360, LDSCTL_OFF = RING_BYTES, MISC_OFF = LDSCTL_OFF + 320, LDS_BYTES = 147456;
constexpr int NWAVES = 8;

#define LDS_WAIT() asm volatile("s_waitcnt lgkmcnt(0)" ::: "memory")
#define VM_WAIT() asm volatile("s_waitcnt vmcnt(0)" ::: "memory")
#define RLX_AGENT __ATOMIC_RELAXED, __HIP_MEMORY_SCOPE_AGENT

__device__ __forceinline__ unsigned cvt_pk_bf16(float lo, float hi) { unsigned r; asm volatile("v_cvt_pk_bf16_f32 %0, %1, %2" : "=v"(r) : "v"(lo), "v"(hi)); return r; }
__device__ __forceinline__ unsigned cvt4_fp8(float a, float b, float c, float d) { int p = __builtin_amdgcn_cvt_pk_fp8_f32(a, b, 0, false); p = __builtin_amdgcn_cvt_pk_fp8_f32(c, d, p, true); return (unsigned)p; }
__device__ __forceinline__ float sat8(float v) { return __builtin_amdgcn_fmed3f(v, -448.f, 448.f); }
__device__ __forceinline__ unsigned cvt4_fp8_sat(float a, float b, float c, float d) { return cvt4_fp8(sat8(a), sat8(b), sat8(c), sat8(d)); }
__device__ __forceinline__ unsigned char fp8_1(float v) { return (unsigned char)__builtin_amdgcn_cvt_pk_fp8_f32(v, v, 0, false); }
__device__ __forceinline__ unsigned quad_tr8(unsigned w, unsigned sel1, unsigned sel2) {
    unsigned p = (unsigned)__builtin_amdgcn_update_dpp(0, (int)w, 0xB1, 0xf, 0xf, false);
    w = __builtin_amdgcn_perm(p, w, sel1);
    p = (unsigned)__builtin_amdgcn_update_dpp(0, (int)w, 0x4E, 0xf, 0xf, false);
    return __builtin_amdgcn_perm(p, w, sel2);
}
constexpr float W8_SCALE = 32.f, W8_INV = 1.f / 32.f;
__device__ __forceinline__ unsigned f2bf(float f) { unsigned u = __builtin_bit_cast(unsigned, f); return (u + 0x7fffu + ((u >> 16) & 1u)) >> 16; }
__device__ __forceinline__ unsigned pk2(float lo, float hi) { return f2bf(lo) | (f2bf(hi) << 16); }
__device__ __forceinline__ float bf2f(unsigned short h) { return __builtin_bit_cast(float, (unsigned)h << 16); }
__device__ __forceinline__ int opaque_tid() { int t = threadIdx.x; asm volatile("" : "+v"(t)); return t; }
template <class T> __device__ __forceinline__ T* launder(T* p) { asm volatile("" : "+v"(p)); return p; }
template <class T> __device__ __forceinline__ GAS T* launder_g(T* p) { GAS T* g = (GAS T*)p; asm volatile("" : "+v"(g)); return g; }
__device__ __forceinline__ float half_sum32(float v) {
    v += __builtin_bit_cast(float, __builtin_amdgcn_update_dpp(0, __builtin_bit_cast(int, v), 0xB1, 0xf, 0xf, false));
    v += __builtin_bit_cast(float, __builtin_amdgcn_update_dpp(0, __builtin_bit_cast(int, v), 0x4E, 0xf, 0xf, false));
    v += __builtin_bit_cast(float, __builtin_amdgcn_update_dpp(0, __builtin_bit_cast(int, v), 0x141, 0xf, 0xf, false));
    v += __builtin_bit_cast(float, __builtin_amdgcn_update_dpp(0, __builtin_bit_cast(int, v), 0x140, 0xf, 0xf, false));
    v += __builtin_bit_cast(float, __builtin_amdgcn_ds_swizzle(__builtin_bit_cast(int, v), 0x401F));
    return v;
}
#define DPPF(x, ctl) __builtin_bit_cast(float, __builtin_amdgcn_update_dpp(0, __builtin_bit_cast(int, (x)), (ctl), 0xf, 0xf, false))
__device__ __forceinline__ float reduce16_row(const float (&v)[16], int lane) {
    const bool b3 = (lane & 8) != 0, b2 = (lane & 4) != 0, b1 = (lane & 2) != 0, b0 = (lane & 1) != 0;
    float w8[8], w4[4], w2[2];
#pragma unroll
    for (int k = 0; k < 8; ++k) { const float keep = b3 ? v[k + 8] : v[k], send = b3 ? v[k] : v[k + 8]; w8[k] = keep + DPPF(send, 0x140); }
#pragma unroll
    for (int k = 0; k < 4; ++k) { const float keep = b2 ? w8[k + 4] : w8[k], send = b2 ? w8[k] : w8[k + 4]; w4[k] = keep + DPPF(send, 0x141); }
#pragma unroll
    for (int k = 0; k < 2; ++k) { const float keep = b1 ? w4[k + 2] : w4[k], send = b1 ? w4[k] : w4[k + 2]; w2[k] = keep + DPPF(send, 0x4E); }
    const float keep = b0 ? w2[1] : w2[0], send = b0 ? w2[0] : w2[1];
    return keep + DPPF(send, 0xB1);
}
__device__ __forceinline__ float reduce16(const float (&v)[16], int lane) {
    float r = reduce16_row(v, lane);
    r += __builtin_bit_cast(float, __builtin_amdgcn_ds_swizzle(__builtin_bit_cast(int, r), 0x401F));
    return r + __shfl_xor(r, 32);
}
__device__ __forceinline__ float row_sum16(float v) { v += DPPF(v, 0xB1); v += DPPF(v, 0x4E); v += DPPF(v, 0x141); v += DPPF(v, 0x140); return v; }
__device__ __forceinline__ float row_max16(float v) { v = fmaxf(v, DPPF(v, 0xB1)); v = fmaxf(v, DPPF(v, 0x4E)); v = fmaxf(v, DPPF(v, 0x141)); v = fmaxf(v, DPPF(v, 0x140)); return v; }
__device__ __forceinline__ unsigned wave_sum_u(unsigned v) {
    v += (unsigned)__builtin_amdgcn_update_dpp(0, (int)v, 0xB1, 0xf, 0xf, false); v += (unsigned)__builtin_amdgcn_update_dpp(0, (int)v, 0x4E, 0xf, 0xf, false);
    v += (unsigned)__builtin_amdgcn_update_dpp(0, (int)v, 0x141, 0xf, 0xf, false); v += (unsigned)__builtin_amdgcn_update_dpp(0, (int)v, 0x140, 0xf, 0xf, false);
    v += (unsigned)__builtin_amdgcn_ds_swizzle((int)v, 0x401F);
    return v + (unsigned)__shfl_xor((int)v, 32);
}
__device__ __forceinline__ float xchg32(float v, bool lo) { unsigned a = __builtin_bit_cast(unsigned, v), b = a; asm volatile("" : "+v"(b)); const auto rr = __builtin_amdgcn_permlane32_swap(a, b, false, false); return __builtin_bit_cast(float, lo ? rr[1] : rr[0]); }
__device__ __forceinline__ float wave_sum(float v) {
    v = half_sum32(v);
    return v + __shfl_xor(v, 32);
}

namespace pg8 {
constexpr int BM = 256, BK = 64, HALF = 128, HTB = HALF * BK * 2, STAGE_BYTES = 8 * HTB, NXCD = 8, WGM = 8;
__host__ __device__ __forceinline__ int lds_byte(int r, int c) { const int st = (r >> 4) * 2 + (c >> 5), rr = r & 15, cc = c & 31, ob = rr * 64 + cc * 2; return st * 1024 + (ob ^ (((ob >> 9) & 1) << 5)); }
__host__ __device__ __forceinline__ void stage_rc(int b, int& R, int& C) { const int st = b / 1024, sb = b % 1024, swz = sb ^ (((sb >> 9) & 1) << 5); R = (st >> 1) * 16 + swz / 64; C = (st & 1) * 32 + (swz % 64) / 2; }
__host__ __device__ __forceinline__ int perm32(int rho) { const int n = rho >> 4, i = rho & 15; return 8 * (i >> 2) + 4 * n + (i & 3); }

struct Unit { int pm, pn, arow0, gadd; const int* gidx; const bf16_t* Bt; int aux; };

typedef int v8i_t __attribute__((ext_vector_type(8)));
typedef v8i_t v8i_a16 __attribute__((aligned(16)));
__device__ __forceinline__ void mma_block8(f32x4 (&c)[4][2], const v8i_t (&At)[4], const v8i_t (&Bt)[2]) {
#pragma unroll
    for (int m = 0; m < 4; ++m)
#pragma unroll
        for (int n = 0; n < 2; ++n) asm volatile("v_mfma_f32_16x16x128_f8f6f4 %0, %1, %2, %0" : "+v"(c[m][n]) : "v"(Bt[n]), "v"(At[m]));
}
__device__ __forceinline__ void mma_block(f32x4 (&c)[4][2], const bf16x8 (&At)[4][2], const bf16x8 (&Bt)[2][2]) {
#pragma unroll
    for (int m = 0; m < 4; ++m)
#pragma unroll
        for (int n = 0; n < 2; ++n)
#pragma unroll
            for (int k = 0; k < 2; ++k) c[m][n] = __builtin_amdgcn_mfma_f32_16x16x32_bf16(Bt[n][k], At[m][k], c[m][n], 0, 0, 0);
}
template <class Epi, class Sched, bool ALIGN_EPI, bool F8 = false>
__device__ __forceinline__ void gemm_phase(LAS unsigned char* lds, const bf16_t* Abase, int K, const Sched& S, const Epi& E) {
    const int tid = opaque_tid(), wid = __builtin_amdgcn_readfirstlane(tid >> 6), lane = tid & 63, wr = wid >> 2, wc = wid & 3, fr = lane & 15, fq = lane >> 4;
    const int rowb = F8 ? K : 2 * K;
    const int nt = rowb / 128;
    int Rr[2], Cc[2]; unsigned voffB[2];
#pragma unroll
    for (int i = 0; i < 2; ++i) { int R, C; stage_rc(tid * 16 + i * 8192, R, C); const int Rb = Epi::PERM ? ((R & ~31) + perm32(R & 31)) : R;
        Rr[i] = R; Cc[i] = C; voffB[i] = (unsigned)(Rb * rowb + C * 2); }
    const size_t kstep = (size_t)(BK * 2);
    const size_t hstep = (size_t)HALF * rowb;
    const unsigned ldsw = (unsigned)wid * 1024u;
    const int aoff = F8 ? lds_byte(wr * 64 + fr, fq * 16) : lds_byte(wr * 64 + fr, fq * 8), boff = F8 ? lds_byte(wc * 32 + fr, fq * 16) : lds_byte(wc * 32 + fr, fq * 8);
    constexpr int KOFF = F8 ? 16 : 1024;
#define PG8_SA(b, h) (((b) * 2 + (h)) * HTB)
#define PG8_SB(b, h) ((4 + (b) * 2 + (h)) * HTB)
#define PG8_STAGE2(bufoff, gbase, v0, v1) do { \
        __builtin_amdgcn_global_load_lds((const unsigned*)((const char*)(gbase) + (v0)), (LAS unsigned*)(lds + (bufoff) + ldsw), 16, 0, 0); \
        __builtin_amdgcn_global_load_lds((const unsigned*)((const char*)(gbase) + (v1)), (LAS unsigned*)(lds + (bufoff) + ldsw + 8192), 16, 0, 0); } while (0)
#define PG8_STAGEB(bufoff, gbase) PG8_STAGE2(bufoff, gbase, voffB[0], voffB[1])
#define PG8_LDA(dst, b, h) do { if constexpr (F8) { _Pragma("unroll") for (int m = 0; m < 4; ++m) dst##8[m] = *(const LAS v8i_a16*)(lds + PG8_SA(b, h) + aoff + m * 2048); } else { _Pragma("unroll") for (int m = 0; m < 4; ++m) _Pragma("unroll") for (int k = 0; k < 2; ++k) dst[m][k] = *(const LAS bf16x8*)(lds + PG8_SA(b, h) + aoff + m * 2048 + k * KOFF); } } while (0)
#define PG8_LDB(dst, b, h) do { if constexpr (F8) { _Pragma("unroll") for (int n = 0; n < 2; ++n) dst##8[n] = *(const LAS v8i_a16*)(lds + PG8_SB(b, h) + boff + n * 2048); } else { _Pragma("unroll") for (int n = 0; n < 2; ++n) _Pragma("unroll") for (int k = 0; k < 2; ++k) dst[n][k] = *(const LAS bf16x8*)(lds + PG8_SB(b, h) + boff + n * 2048 + k * KOFF); } } while (0)
#define PG8_MMA(ai, bj, At, Bt) do { __builtin_amdgcn_s_setprio(1); if constexpr (F8) mma_block8(acc[ai][bj], At##8, Bt##8); else mma_block(acc[ai][bj], At, Bt); __builtin_amdgcn_s_setprio(0); } while (0)
#define PG8_WAIT_V(n) asm volatile("s_waitcnt vmcnt(" #n ")" ::: "memory")
#define PG8_WAIT_L(n) asm volatile("s_waitcnt lgkmcnt(" #n ")" ::: "memory")
#define PG8_BAR __builtin_amdgcn_s_barrier()
#define PG8_SCHED __builtin_amdgcn_sched_barrier(0)
#define PG8_AOFF(u, VA) do { _Pragma("unroll") for (int h_ = 0; h_ < 2; ++h_) _Pragma("unroll") for (int i_ = 0; i_ < 2; ++i_) { const int rl_ = h_ * HALF + Rr[i_]; \
        const int gr_ = (u).gidx ? ((u).gadd + (u).gidx[rl_]) : ((u).arow0 + rl_); VA[h_][i_] = (unsigned)(gr_ * rowb + Cc[i_] * 2); } } while (0)
    Unit cur, nxt; int ui = 0;
    if (!S.next(0, cur)) return;
    f32x4 acc[2][2][4][2];
#pragma unroll
    for (int a = 0; a < 2; ++a)
#pragma unroll
        for (int b = 0; b < 2; ++b)
#pragma unroll
            for (int m = 0; m < 4; ++m)
#pragma unroll
                for (int n = 0; n < 2; ++n) acc[a][b][m][n] = (f32x4){0.f, 0.f, 0.f, 0.f};
    bf16x8 At[4][2], B0[2][2], B1[2][2]; v8i_t At8[4], B08[2], B18[2];
    unsigned cVA[2][2], nVA[2][2];
    PG8_AOFF(cur, cVA);
    const char* const A0 = (const char*)Abase;
    const char* cB = (const char*)cur.Bt;
    PG8_STAGEB(PG8_SB(0, 0), cB); PG8_STAGEB(PG8_SB(0, 1), cB + hstep); PG8_STAGE2(PG8_SA(0, 0), A0, cVA[0][0], cVA[0][1]); PG8_STAGE2(PG8_SA(0, 1), A0, cVA[1][0], cVA[1][1]);
    if (wr == 1) PG8_BAR;
    PG8_WAIT_V(2); PG8_BAR;
    PG8_STAGEB(PG8_SB(1, 0), cB + kstep); PG8_STAGE2(PG8_SA(1, 0), A0 + kstep, cVA[0][0], cVA[0][1]); PG8_STAGEB(PG8_SB(1, 1), cB + hstep + kstep);
    PG8_WAIT_V(6); PG8_BAR;
    Unit nn; unsigned nnVA[2][2];
    bool has_next = S.next(1, nxt);
    if (has_next) { PG8_AOFF(nxt, nVA); } else {
#pragma unroll
        for (int h_ = 0; h_ < 2; ++h_)
#pragma unroll
            for (int i_ = 0; i_ < 2; ++i_) nVA[h_][i_] = cVA[h_][i_]; }
    for (;;) {
        const char* nB = has_next ? (const char*)nxt.Bt : cB;
        for (int t = 0; t < nt; t += 2) {
            const bool last = (t == nt - 2);
            const char* a1 = A0 + (size_t)(t + 1) * kstep;
            const char* a2 = last ? A0 : A0 + (size_t)(t + 2) * kstep; const char* b2 = last ? nB : cB + (size_t)(t + 2) * kstep;
            const char* a3 = a2 + kstep; const char* b3 = b2 + kstep;
            const unsigned x00 = last ? nVA[0][0] : cVA[0][0], x01 = last ? nVA[0][1] : cVA[0][1], x10 = last ? nVA[1][0] : cVA[1][0], x11 = last ? nVA[1][1] : cVA[1][1];
            PG8_LDB(B0, 0, 0); PG8_LDB(B1, 0, 1); PG8_SCHED; PG8_LDA(At, 0, 0); PG8_STAGE2(PG8_SA(1, 1), a1, cVA[1][0], cVA[1][1]);
            PG8_WAIT_V(8); PG8_WAIT_L(0); PG8_BAR; PG8_MMA(0, 0, At, B0); PG8_MMA(0, 1, At, B1); PG8_BAR; PG8_SCHED;
            PG8_LDA(At, 0, 1); PG8_STAGEB(PG8_SB(0, 0), b2); PG8_STAGEB(PG8_SB(0, 1), b2 + hstep); PG8_STAGE2(PG8_SA(0, 0), a2, x00, x01);
            PG8_WAIT_V(8); PG8_WAIT_L(0); PG8_BAR; PG8_MMA(1, 0, At, B0); PG8_MMA(1, 1, At, B1); PG8_BAR; PG8_SCHED;
            PG8_LDB(B0, 1, 0); PG8_LDB(B1, 1, 1); PG8_SCHED; PG8_LDA(At, 1, 0); PG8_STAGE2(PG8_SA(0, 1), a2, x10, x11);
            PG8_WAIT_V(8); PG8_WAIT_L(0); PG8_BAR; PG8_MMA(0, 0, At, B0); PG8_MMA(0, 1, At, B1); PG8_BAR; PG8_SCHED;
            PG8_LDA(At, 1, 1); PG8_STAGEB(PG8_SB(1, 0), b3); PG8_STAGEB(PG8_SB(1, 1), b3 + hstep); PG8_STAGE2(PG8_SA(1, 0), a3, x00, x01);
            PG8_WAIT_V(8); PG8_WAIT_L(0); PG8_BAR; PG8_MMA(1, 0, At, B0); PG8_MMA(1, 1, At, B1); PG8_BAR; PG8_SCHED;
        }
        if constexpr (ALIGN_EPI) { if (wr == 0) PG8_BAR; }
        if constexpr (F8) asm volatile("s_nop 15\n\ts_nop 15" ::: "memory");
        const bool has_nn = has_next && S.next(ui + 2, nn);
        if (has_nn) { PG8_AOFF(nn, nnVA); }
        E(acc, cur, wr, wc, fr, fq);
        if (!has_next) break;
#pragma unroll
        for (int a = 0; a < 2; ++a)
#pragma unroll
            for (int b = 0; b < 2; ++b)
#pragma unroll
                for (int m = 0; m < 4; ++m)
#pragma unroll
                    for (int n = 0; n < 2; ++n) acc[a][b][m][n] = (f32x4){0.f, 0.f, 0.f, 0.f};
        cur = nxt; cB = nB; ++ui;
#pragma unroll
        for (int h_ = 0; h_ < 2; ++h_)
#pragma unroll
            for (int i_ = 0; i_ < 2; ++i_) { cVA[h_][i_] = nVA[h_][i_]; if (has_nn) nVA[h_][i_] = nnVA[h_][i_]; }
        has_next = has_nn; if (has_nn) nxt = nn;
        if constexpr (ALIGN_EPI) { if (wr == 1) PG8_BAR; }
    }
    PG8_WAIT_V(0);
    if constexpr (!ALIGN_EPI) { if (wr == 0) PG8_BAR; }
    PG8_BAR;
#undef PG8_SA
#undef PG8_SB
#undef PG8_STAGE2
#undef PG8_STAGEB
#undef PG8_LDA
#undef PG8_LDB
#undef PG8_MMA
#undef PG8_WAIT_V
#undef PG8_WAIT_L
#undef PG8_BAR
#undef PG8_SCHED
#undef PG8_AOFF
}
}

#define XB_TMO      128
#define XB_XCNT(j)  (256  + 64 * (j))
#define XB_XSUB(j)  (1280 + 64 * (j))
#define XB_XGEN(j)  (2304 + 64 * (j))
#define XB_TOP      3328
#define XB_TOPGEN   3392
#define XCD_BAR_WORDS 3456
#define XB_LSUB(j)  (3456 + 64 * (j))
#define XB_LGEN(j)  (4480 + 64 * (j))
#define XB_GMAX(g)  (5504 + 64 * (g))
#define XB_GMIN(g)  (6016 + 64 * (g))
#define XB_MODF     6528
#define XB_SPIN_CAP (1u << 22)
__device__ __forceinline__ unsigned xb_ld(unsigned* p)              { return __hip_atomic_load(p, __ATOMIC_RELAXED, __HIP_MEMORY_SCOPE_AGENT); }
__device__ __forceinline__ unsigned xb_add(unsigned* p, unsigned v) { return __hip_atomic_fetch_add(p, v, __ATOMIC_RELAXED, __HIP_MEMORY_SCOPE_AGENT); }
__device__ __forceinline__ unsigned xb_xcc_id() { return (unsigned)__builtin_amdgcn_s_getreg((3 << 11) | 20) & 0xFu; }
#define XB_SPIN(cond, bar) do { unsigned _sp = 0; while (cond) { __builtin_amdgcn_s_sleep(1); \
    if ((++_sp & 255u) == 0u) { if (xb_ld(&(bar)[XB_TMO])) break; if (_sp > XB_SPIN_CAP) { atomicAdd(&(bar)[XB_TMO], 1u); break; } } } } while (0)
struct XcdBarrier { unsigned* bar; unsigned x; volatile LAS unsigned* st; };
__device__ __forceinline__ XcdBarrier xcd_barrier_post(unsigned* bar, volatile LAS unsigned* st) {
    XcdBarrier b; b.bar = bar; b.x = xb_xcc_id(); b.st = st;
    if (threadIdx.x == 0) (void)xb_add(&bar[XB_XCNT(b.x)], 1u);
    return b;
}
__device__ __forceinline__ void xcd_barrier_complete(unsigned* bar, unsigned x, unsigned& nloc, unsigned& nx) {
    const unsigned G = gridDim.x * gridDim.y * gridDim.z;
    unsigned sum, cnt, mine, sp = 0u;
    for (;;) {
        sum = 0u; cnt = 0u; mine = 0u;
#pragma unroll
        for (unsigned j = 0; j < 16; ++j) { const unsigned c = xb_ld(&bar[XB_XCNT(j)]); sum += c; cnt += (c > 0u) ? 1u : 0u; mine = (j == x) ? c : mine; }
        if (sum == G) break;
        __builtin_amdgcn_s_sleep(1);
        if ((++sp & 255u) == 0u) { if (xb_ld(&bar[XB_TMO])) break; if (sp > XB_SPIN_CAP) { atomicAdd(&bar[XB_TMO], 1u); break; } }
    }
    nloc = mine > 0u ? mine : 1u; nx = cnt > 0u ? cnt : 1u;
}
__device__ __forceinline__ void xcd_barrier(const XcdBarrier& b) {
    asm volatile("s_waitcnt vmcnt(0)" ::: "memory");
    __syncthreads();
    if (threadIdx.x == 0) {
        unsigned* bar = b.bar;
        __builtin_amdgcn_s_waitcnt(0);
        unsigned nloc = b.st[0], nx = b.st[1];
        if (nloc == 0u) { xcd_barrier_complete(bar, b.x, nloc, nx); b.st[0] = nloc; b.st[1] = nx; }
        const unsigned old = xb_add(&bar[XB_XSUB(b.x)], 1u);
        const unsigned gen = old / nloc;
        if (old + 1u == (gen + 1u) * nloc) {
            __builtin_amdgcn_fence(__ATOMIC_RELEASE, "agent");
            asm volatile("s_waitcnt vmcnt(0)" ::: "memory");
            const unsigned og = xb_add(&bar[XB_TOP], 1u);
            const unsigned tg = og / nx;
            asm volatile("buffer_inv sc1" ::: "memory");
            if (og + 1u == (tg + 1u) * nx) xb_add(&bar[XB_TOPGEN], 1u);
            else XB_SPIN(xb_ld(&bar[XB_TOPGEN]) == tg, bar);
            asm volatile("s_waitcnt vmcnt(0)" ::: "memory");
            xb_add(&bar[XB_XGEN(b.x)], 1u);
            asm volatile("s_waitcnt vmcnt(0)" ::: "memory");
        } else {
            if (old == gen * nloc) __builtin_amdgcn_fence(__ATOMIC_RELEASE, "agent");
            asm volatile("buffer_inv sc1" ::: "memory");
            XB_SPIN(xb_ld(&bar[XB_XGEN(b.x)]) == gen, bar);
            asm volatile("s_waitcnt vmcnt(0)" ::: "memory");
        }
    }
    __syncthreads();
}

__device__ __forceinline__ void xcd_barrier_local(const XcdBarrier& b) {
    asm volatile("s_waitcnt vmcnt(0)" ::: "memory");
    __syncthreads();
    if (threadIdx.x == 0) {
        unsigned* bar = b.bar;
        __builtin_amdgcn_s_waitcnt(0);
        unsigned nloc = b.st[0], nx = b.st[1];
        if (nloc == 0u) { xcd_barrier_complete(bar, b.x, nloc, nx); b.st[0] = nloc; b.st[1] = nx; }
        const unsigned old = xb_add(&bar[XB_LSUB(b.x)], 1u);
        const unsigned gen = old / nloc;
        asm volatile("buffer_inv sc1" ::: "memory");
        if (old + 1u == (gen + 1u) * nloc) xb_add(&bar[XB_LGEN(b.x)], 1u);
        else XB_SPIN(xb_ld(&bar[XB_LGEN(b.x)]) == gen, bar);
        asm volatile("s_waitcnt vmcnt(0)" ::: "memory");
    }
    __syncthreads();
}

struct Args {
    const float* x; const float* c; const float* ctx; const float* c_ctx; const float* w_ada; const float* b_ada;
    const float* n_pre_mix; const float* n_post_mix; const float* n_pre_ffn; const float* n_post_ffn;
    const float* w_in; const float* lq1; const float* lk1; const float* lq2; const float* lk2; const float* da_subln;
    const float* hglb; const float* hg_norm; const float* w_out; const float* w_router; const float* w_gate; const float* w_up; const float* w_down;
    float* out; unsigned char* ws; int ph_lo, ph_hi;
};

struct Frame {
    LAS unsigned char* lds; volatile LAS unsigned* MISC; gu32* ctl;
    int tid, lane, wave, vcu, G;
    int grp, rk;
    int p7_gw, p7_ngw, p7_lim;
};

struct P0Item { const float* W; bf16_t* WT; int drow0; int ilv; int r; };
__device__ __forceinline__ void p0_item_load(const float* W, int N, int item, int lane, float (&wv)[32]) {
    const int nblk = N / 32, kb = item / nblk, nb = item % nblk, k0 = 64 * kb, n0 = 32 * nb;
    const GAS float* p = (const GAS float*)(W + (size_t)(k0 + (lane >> 5)) * N + n0 + (lane & 31));
#pragma unroll
    for (int i = 0; i < 32; ++i) wv[i] = __builtin_nontemporal_load(p + (size_t)(2 * i) * N);
}
__device__ __forceinline__ void p0_item_store8(const float (&wv)[32], int K, int N, unsigned char* WT, int drow0, bool ilv, LAS float* scr, int item, int lane, bool rperm = false) {
    const int nblk = N / 32, kb = item / nblk, nb = item % nblk, k0 = 64 * kb, n0 = 32 * nb;
#pragma unroll
    for (int i = 0; i < 32; ++i) scr[(2 * i + (lane >> 5)) * 33 + (lane & 31)] = wv[i];
    LDS_WAIT(); asm volatile("" ::: "memory");
    const int c = lane & 7;
    const int dr = drow0 + (ilv ? ((n0 >> 7) * 256 + (n0 & 127)) : n0);
#pragma unroll
    for (int j = 0; j < 4; ++j) { const int n = (lane >> 3) + 8 * j; const LAS float* s = scr + (8 * c) * 33 + n;
        u32x2 o; o.x = cvt4_fp8(s[0 * 33] * W8_SCALE, s[1 * 33] * W8_SCALE, s[2 * 33] * W8_SCALE, s[3 * 33] * W8_SCALE); o.y = cvt4_fp8(s[4 * 33] * W8_SCALE, s[5 * 33] * W8_SCALE, s[6 * 33] * W8_SCALE, s[7 * 33] * W8_SCALE);
        const int nd = (rperm && n0 < 1024) ? (((n >> 2) & 3) * 8 + (n >> 4) * 4 + (n & 3)) : n;
        *(GAS u32x2*)(WT + (size_t)(dr + nd) * K + k0 + 8 * c) = o; }
    LDS_WAIT(); asm volatile("" ::: "memory");
}
__device__ __forceinline__ void p0_item_store(const float (&wv)[32], int K, int N, bf16_t* WT, int drow0, bool ilv, LAS float* scr, int item, int lane, bool rperm = false) {
    const int nblk = N / 32, kb = item / nblk, nb = item % nblk, k0 = 64 * kb, n0 = 32 * nb;
#pragma unroll
    for (int i = 0; i < 32; ++i) scr[(2 * i + (lane >> 5)) * 33 + (lane & 31)] = wv[i];
    LDS_WAIT(); asm volatile("" ::: "memory");
    const int c = lane & 7;
    const int dr = drow0 + (ilv ? ((n0 >> 7) * 256 + (n0 & 127)) : n0);
#pragma unroll
    for (int j = 0; j < 4; ++j) { const int n = (lane >> 3) + 8 * j; const LAS float* s = scr + (8 * c) * 33 + n;
        u32x4 o; o.x = cvt_pk_bf16(s[0 * 33], s[1 * 33]); o.y = cvt_pk_bf16(s[2 * 33], s[3 * 33]); o.z = cvt_pk_bf16(s[4 * 33], s[5 * 33]); o.w = cvt_pk_bf16(s[6 * 33], s[7 * 33]);
        const int nd = (rperm && n0 < 1024) ? (((n >> 2) & 3) * 8 + (n >> 4) * 4 + (n & 3)) : n;
        *(GAS u32x4*)(WT + (size_t)(dr + nd) * K + k0 + 8 * c) = o; }
    LDS_WAIT(); asm volatile("" ::: "memory");
}

__device__ __forceinline__ float silu_f(float v) { return v * __builtin_amdgcn_rcpf(1.f + __expf(-v)); }

constexpr int P0_I_IN = 16 * 128, P0_I_OUT = 16 * 32, P0_I_E = 16 * 32;
constexpr int P0_ITEMS_EARLY = P0_I_IN + P0_I_OUT + 2 * NEXP * P0_I_E, P0_ITEMS_ALL = P0_I_IN + P0_I_OUT + 3 * NEXP * P0_I_E;
__device__ __forceinline__ void convert_items(Frame& F, const Args& a, int lo, int hi, int gw, int NGW, int wave_, int lane_, int remap_g = -1) {
    LAS float* scr = (LAS float*)(F.lds + wave_ * 16384);
    constexpr int I_IN = P0_I_IN, I_OUT = P0_I_OUT, I_E = P0_I_E;
    const int NITEMS = hi;
    bf16_t* win_t = (bf16_t*)(a.ws + WS_WIN); bf16_t* wout_t = (bf16_t*)(a.ws + WS_WOUT); unsigned char* wgu_t = a.ws + WS_WGU; unsigned char* wd_t = a.ws + WS_WD;
#define P0_DECODE(it_, W_, N_, WT_, D0_, ILV_, R_) do { int r_ = (it_); \
        if (r_ < I_IN) { W_ = a.w_in; N_ = 4096; WT_ = (unsigned char*)win_t; D0_ = 0; ILV_ = 4; R_ = r_; } \
        else if ((r_ -= I_IN) < I_OUT) { W_ = a.w_out; N_ = 1024; WT_ = (unsigned char*)wout_t; D0_ = 0; ILV_ = 2; R_ = r_; }        \
        else { r_ -= I_OUT; const int mat_ = r_ / (NEXP * I_E); r_ -= mat_ * (NEXP * I_E); const int e_ = r_ / I_E; r_ -= e_ * I_E; N_ = 1024; R_ = r_; \
            if (mat_ == 0) { W_ = a.w_gate + (size_t)e_ * 1048576; WT_ = wgu_t + (size_t)e_ * 2097152; D0_ = 0; ILV_ = 3; } \
            else if (mat_ == 1) { W_ = a.w_up + (size_t)e_ * 1048576; WT_ = wgu_t + (size_t)e_ * 2097152; D0_ = 128; ILV_ = 3; } \
            else { W_ = a.w_down + (size_t)e_ * 1048576; WT_ = wd_t + (size_t)e_ * 1048576; D0_ = 0; ILV_ = 2; } } } while (0)
#define P0_STORE(wv_, N_, WT_, D0_, ILV_, R_) do { if ((ILV_) & 2) p0_item_store8(wv_, 1024, N_, WT_, D0_, ((ILV_) & 1) != 0, scr, R_, lane_); else { if ((ILV_) & 4) p0_item_store8(wv_, 1024, N_, a.ws + WS_WIN8, D0_, false, scr, R_, lane_, true); else p0_item_store(wv_, 1024, N_, (bf16_t*)(WT_), D0_, false, scr, R_, lane_, false); } } while (0)
#define P0_RI(j) (remap_g < 0 ? (j) : (P0_ITEMS_EARLY + (((j) >> 9) ? remap_g + 8 : remap_g) * I_E + ((j) & 511)))
    float wa[32], wb[32];
    const float* Wc; int Nc; unsigned char* WTc; int D0c; int ILVc; int Rc;
    int it = lo + gw;
    if (it < NITEMS) { P0_DECODE(P0_RI(it), Wc, Nc, WTc, D0c, ILVc, Rc); p0_item_load(Wc, Nc, Rc, lane_, wa); }
    while (it < NITEMS) {
        const int it1 = it + NGW; const float* W1 = Wc; int N1 = Nc; unsigned char* WT1 = WTc; int D01 = D0c; int ILV1 = ILVc; int R1 = Rc;
        if (it1 < NITEMS) { P0_DECODE(P0_RI(it1), W1, N1, WT1, D01, ILV1, R1); p0_item_load(W1, N1, R1, lane_, wb); }
        P0_STORE(wa, Nc, WTc, D0c, ILVc, Rc);
        if (it1 >= NITEMS) break;
        const int it2 = it1 + NGW;
        if (it2 < NITEMS) { P0_DECODE(P0_RI(it2), Wc, Nc, WTc, D0c, ILVc, Rc); p0_item_load(Wc, Nc, Rc, lane_, wa); }
        P0_STORE(wb, N1, WT1, D01, ILV1, R1);
        it = it2;
    }
#undef P0_DECODE
#undef P0_STORE
#undef P0_RI
}

__device__ __forceinline__ void p0_prologue(Frame& F, const Args& a) {
    const int tid_ = opaque_tid(), lane_ = tid_ & 63; const int wave_ = __builtin_amdgcn_readfirstlane(tid_ >> 6);
    if (blockIdx.x < 96) {
        LAS float* sv = (LAS float*)(F.lds);
        LAS float* part = (LAS float*)(F.lds + 16384);
        for (int i = tid_; i < 3072; i += 512) { const int j = i >> 10, k = i & 1023; const float v = (j < 2) ? a.c[j * 1024 + k] : a.c_ctx[k]; sv[i] = silu_f(v); }
        __syncthreads();
        const int col = blockIdx.x * 64 + lane_; const int kb = wave_ * 128;
        float s0 = 0.f, s1 = 0.f, s2 = 0.f;
#pragma unroll 1
        for (int k0 = 0; k0 < 128; k0 += 32) {
            float w[32];
#pragma unroll
            for (int k = 0; k < 32; ++k) w[k] = __builtin_nontemporal_load(a.w_ada + (size_t)(kb + k0 + k) * 6144 + col);
#pragma unroll
            for (int k = 0; k < 32; ++k) { s0 += sv[kb + k0 + k] * w[k]; s1 += sv[1024 + kb + k0 + k] * w[k]; s2 += sv[2048 + kb + k0 + k] * w[k]; }
        }
        part[(wave_ * 3 + 0) * 64 + lane_] = s0; part[(wave_ * 3 + 1) * 64 + lane_] = s1; part[(wave_ * 3 + 2) * 64 + lane_] = s2;
        __syncthreads();
        if (tid_ < 192) { const int j = tid_ >> 6, l = tid_ & 63; float s = a.b_ada[blockIdx.x * 64 + l];
#pragma unroll
            for (int w = 0; w < 8; ++w) s += part[(w * 3 + j) * 64 + l];
            float* mp_ = (float*)(a.ws + WS_MOD) + j * 6144 + blockIdx.x * 64 + l;
            asm volatile("global_store_dword %0, %1, off sc0 sc1" :: "v"(mp_), "v"(s) : "memory"); }
        asm volatile("s_waitcnt vmcnt(0)" ::: "memory");
        __syncthreads();
        if (tid_ == 0) (void)xb_add((unsigned*)(F.ctl + CW_BAR) + XB_MODF, 1u);
    } else if (blockIdx.x < 128) {
        if (tid_ < 64) { const int e = ((int)blockIdx.x - 96) * 64 + tid_; const int pos = e >> 4, j = e & 15;
            const double inv = exp(-(double)j * (1.0 / 16.0) * 9.210340371976184); const double ang = (double)pos * inv;
            f32x2 v; v.x = (float)cos(ang); v.y = (float)sin(ang); ((f32x2*)(a.ws + WS_ROPE))[e] = v; }
    }
    if (F.G == 256) {
        constexpr int SPLIT = 13824;
        convert_items(F, a, 0, SPLIT, F.vcu * NWAVES + wave_, F.G * NWAVES, wave_, lane_);
        if (blockIdx.x >= 96) convert_items(F, a, SPLIT, P0_ITEMS_EARLY, ((int)blockIdx.x - 96) * NWAVES + wave_, (F.G - 96) * NWAVES, wave_, lane_);
    } else convert_items(F, a, 0, P0_ITEMS_EARLY, F.vcu * NWAVES + wave_, F.G * NWAVES, wave_, lane_);
}

struct P1Rows { f32x4 xn[2][4]; };
__device__ __forceinline__ const float* p1_src(const Args& a, int R) { const int b = R >= RB ? 1 : 0, rr = R - b * RB; return rr < CTXL ? a.ctx + (size_t)(b * CTXL + rr) * DM : a.x + (size_t)(b * SEQ + rr - CTXL) * DM; }
__device__ __forceinline__ void p1_load(const Args& a, int q0, int NGW, int lane_, P1Rows& st) {
    const int q1 = q0 + NGW < MR ? q0 + NGW : q0;
    const GAS f32x4* x0 = (const GAS f32x4*)p1_src(a, q0) + lane_; const GAS f32x4* x1 = (const GAS f32x4*)p1_src(a, q1) + lane_;
#pragma unroll
    for (int j = 0; j < 4; ++j) { st.xn[0][j] = __builtin_nontemporal_load(x0 + 64 * j); st.xn[1][j] = __builtin_nontemporal_load(x1 + 64 * j); }
}
__device__ __forceinline__ void p1_pre(Frame& F, const Args& a, P1Rows& st) {
    const int tid_ = opaque_tid(), lane_ = tid_ & 63; const int wave_ = __builtin_amdgcn_readfirstlane(tid_ >> 6);
    const int gw = (int)blockIdx.x * NWAVES + wave_, NGW = F.G * NWAVES;
    if (gw < MR) p1_load(a, gw, NGW, lane_, st);
}
__device__ __forceinline__ void p1_norm(Frame& F, const Args& a, P1Rows& st) {
    const int tid_ = opaque_tid(), lane_ = tid_ & 63; const int wave_ = __builtin_amdgcn_readfirstlane(tid_ >> 6);
    LAS float* par = (LAS float*)F.lds;
    const float* mod = (const float*)(a.ws + WS_MOD);
    if (tid_ == 0) { unsigned* mf = (unsigned*)(F.ctl + CW_BAR) + XB_MODF; XB_SPIN(xb_ld(mf) < 96u, (unsigned*)(F.ctl + CW_BAR)); __builtin_amdgcn_fence(__ATOMIC_ACQUIRE, "agent"); }
    __syncthreads();
    for (int i = tid_; i < 3072; i += 512) { const int v = i >> 10, c = i & 1023;
        par[v * 2048 + c] = a.n_pre_mix[c] * (1.f + mod[v * 6144 + 1024 + c]); par[v * 2048 + 1024 + c] = mod[v * 6144 + c]; }
    __syncthreads();
    bf16_t* hn = (bf16_t*)(a.ws + WS_HN);
    const bool cwg = false;
    const int gw = (int)blockIdx.x * NWAVES + wave_, NGW = F.G * NWAVES;
    const int nrows = MR;
    for (int q0 = gw; q0 < nrows; q0 += 2 * NGW) {
        const int q1 = q0 + NGW; const bool v1 = q1 < nrows;
        int Rr[2]; const float* srcp[2]; int var[2];
#pragma unroll
        for (int u = 0; u < 2; ++u) { const int q = (u == 0 || v1) ? (u ? q1 : q0) : q0;
            const int R = q; (void)cwg;
            const int b = R >= RB ? 1 : 0, rr = R - b * RB; const bool isctx = rr < CTXL;
            Rr[u] = R; srcp[u] = isctx ? a.ctx + (size_t)(b * CTXL + rr) * DM : a.x + (size_t)(b * SEQ + rr - CTXL) * DM; var[u] = isctx ? 2 : b; }
        f32x4 xv[2][4]; float ss[2] = {0.f, 0.f};
#pragma unroll
        for (int u = 0; u < 2; ++u)
#pragma unroll
            for (int j = 0; j < 4; ++j) xv[u][j] = st.xn[u][j];
        if (q0 + 2 * NGW < nrows) p1_load(a, q0 + 2 * NGW, NGW, lane_, st);
#pragma unroll
        for (int u = 0; u < 2; ++u)
#pragma unroll
            for (int j = 0; j < 4; ++j) ss[u] += (xv[u][j].x * xv[u][j].x + xv[u][j].y * xv[u][j].y) + (xv[u][j].z * xv[u][j].z + xv[u][j].w * xv[u][j].w);
        ss[0] = wave_sum(ss[0]); ss[1] = wave_sum(ss[1]);
#pragma unroll
        for (int u = 0; u < 2; ++u) { if (u == 1 && !v1) break;
            const float rstd = __builtin_amdgcn_rsqf(ss[u] * (1.f / DM) + NORM_EPS);
            GAS unsigned long long* o8 = (GAS unsigned long long*)(hn + (size_t)Rr[u] * DM) + lane_;
            GAS unsigned* o4 = (GAS unsigned*)(a.ws + WS_HN8 + (size_t)Rr[u] * DM) + lane_;
#pragma unroll
            for (int j = 0; j < 4; ++j) { const int c = 4 * lane_ + 256 * j;
                const f32x4 sc = *(const LAS f32x4*)(par + var[u] * 2048 + c), sh = *(const LAS f32x4*)(par + var[u] * 2048 + 1024 + c);
                const f32x4 h = xv[u][j] * rstd * sc + sh;
                o4[64 * j] = cvt4_fp8_sat(h.x, h.y, h.z, h.w); } }
    }
    __syncthreads();
}

struct SchedInProj {
    int nM, nN, nwg, G, c; const bf16_t* Bt; int K;
    __device__ bool next(int i, pg8::Unit& u) const {
        const long L = (long)i * G + c; if (L >= nwg) return false;
        int wgid = (int)L; { const int q = nwg / 8, r = nwg % 8, xcd = wgid % 8, off = wgid / 8; wgid = (xcd < r ? xcd * (q + 1) : r * (q + 1) + (xcd - r) * q) + off; }
        const int nig = 8 * nN, gid = wgid / nig, fm = gid * 8, gsz = (nM - fm) < 8 ? (nM - fm) : 8;
        const int lt = fm + ((wgid % nig) % gsz);
        u.pm = lt + 1 + (lt >= 32 ? 1 : 0); u.pn = (wgid % nig) / gsz; u.arow0 = u.pm * 256; u.gadd = 0; u.gidx = nullptr; u.Bt = Bt + (size_t)u.pn * 256 * K; u.aux = 0; return true;
    }
};
struct EpiInProj {
    static constexpr bool PERM = true;
    bf16_t* P; bf16_t* KI; bf16_t* VI; const f32x2* cs; const float* hglb;
    __device__ __forceinline__ void operator()(const f32x4 (&acc)[2][2][4][2], const pg8::Unit& u, int wr, int wc, int fr, int fq) const {
        const int region = u.pn >> 1;
        const int b = (u.pm >= 33) ? 1 : 0; const bool isctx = (u.pm == 0 || u.pm == 33);
        if (isctx && (region == 0 || region >= 6)) return;
        const int pcol = (region == 0 ? u.pn * 256 : u.pn * 256 - 1024) + wc * 32 + 8 * fq;
        float lbv[2][8];
        if (region == 3 || region == 4) {
            const int d = region - 3;
#pragma unroll
            for (int bj = 0; bj < 2; ++bj) { const int cc = (u.pn & 1) * 256 + bj * 128 + wc * 32 + 8 * fq;
#pragma unroll
                for (int n = 0; n < 2; ++n) { const f32x4 a0 = *(const f32x4*)(hglb + d * 512 + cc + 4 * n), a1 = *(const f32x4*)(hglb + 1024 + d * 512 + cc + 4 * n);
#pragma unroll
                    for (int i = 0; i < 4; ++i) lbv[bj][4 * n + i] = 1.f - __builtin_amdgcn_rcpf(1.f + __expf(a1[i] - a0[i])); } }
        }
#pragma unroll
        for (int ai = 0; ai < 2; ++ai)
#pragma unroll
            for (int m = 0; m < 4; ++m) {
                const int R = u.pm * 256 + ai * 128 + wr * 64 + m * 16 + fr;
                const int rr = R - b * RB, t = rr - CTXL;
                float co[4] = {0.f, 0.f, 0.f, 0.f}, si[4] = {0.f, 0.f, 0.f, 0.f};
                const float rsc = region == 0 ? W8_INV * QSCALE : W8_INV;
                if (region <= 1 && !isctx) {
                    const int pos = (wc & 1) ? (t & 63) : (t >> 6);
                    const f32x4* cp = (const f32x4*)(cs + pos * 16 + 4 * fq);
                    const f32x4 c0 = cp[0], c1 = cp[1];
                    co[0] = c0.x * rsc; co[1] = c0.z * rsc; co[2] = c1.x * rsc; co[3] = c1.z * rsc; si[0] = c0.y * rsc; si[1] = c0.w * rsc; si[2] = c1.y * rsc; si[3] = c1.w * rsc;
                }
#pragma unroll
                for (int bj = 0; bj < 2; ++bj) {
                    float v[8];
#pragma unroll
                    for (int i = 0; i < 4; ++i) { v[i] = acc[ai][bj][m][0][i]; v[4 + i] = acc[ai][bj][m][1][i]; }
                    if (region <= 1) {
                        if (!isctx) {
#pragma unroll
                            for (int i = 0; i < 4; ++i) { const float x1 = v[i], x2 = v[4 + i]; v[i] = x1 * co[i] - x2 * si[i]; v[4 + i] = x2 * co[i] + x1 * si[i]; }
                        } else {
#pragma unroll
                            for (int i = 0; i < 8; ++i) v[i] *= rsc; }
                        if (region == 0) { u32x2 wl, wh; wl.x = cvt_pk_bf16(v[0], v[1]); wl.y = cvt_pk_bf16(v[2], v[3]); wh.x = cvt_pk_bf16(v[4], v[5]); wh.y = cvt_pk_bf16(v[6], v[7]);
                            bf16_t* qd = P + (size_t)R * NPJ + u.pn * 256 + bj * 128 + wc * 32 + 4 * fq; *(u32x2*)qd = wl; *(u32x2*)(qd + 16) = wh; }
                        else {
                            const unsigned k0 = cvt4_fp8_sat(v[0], v[1], v[2], v[3]), k1 = cvt4_fp8_sat(v[4], v[5], v[6], v[7]);
                            const int tl = __builtin_amdgcn_readfirstlane((b * 4 + (u.pn & 1) * 2 + bj) * 132 + (rr >> 6));
                            unsigned char* tb = (unsigned char*)KI + (size_t)tl * 8192 + (wc >> 1) * 4096;
                            unsigned ko = (unsigned)(fr * 64 + 4 * fq + (((2 * (wc & 1)) ^ ((fr >> 2) & 3)) * 16));
                            asm volatile("" : "+v"(ko));
                            *(unsigned*)(tb + (ko + m * 1024)) = k0; *(unsigned*)(tb + ((ko ^ 16u) + m * 1024)) = k1; }
                        continue;
                    } else if (region == 3 || region == 4) {
#pragma unroll
                        for (int i = 0; i < 8; ++i) v[i] = lbv[bj][i] * __builtin_amdgcn_rcpf(1.f + __builtin_amdgcn_exp2f(v[i] * (W8_INV * 1.4426950408889634f)));
                    } else if (region == 7) {
#pragma unroll
                        for (int i = 0; i < 8; ++i) v[i] = silu_f(v[i] * W8_INV);
                    } else {
#pragma unroll
                        for (int i = 0; i < 8; ++i) v[i] *= W8_INV;
                    }
                    if (region == 2) {
                        const int L = fr & 3;
                        const unsigned sel1 = (L & 1) ? 0x03070105u : 0x06020400u, sel2 = (L & 2) ? 0x03020706u : 0x05040100u;
                        const unsigned w0 = quad_tr8(cvt4_fp8_sat(v[0], v[1], v[2], v[3]), sel1, sel2), w1 = quad_tr8(cvt4_fp8_sat(v[4], v[5], v[6], v[7]), sel1, sel2);
                        const int tl = __builtin_amdgcn_readfirstlane((b * 4 + (u.pn & 1) * 2 + bj) * 132 + (rr >> 6));
                        unsigned char* tb = (unsigned char*)VI + (size_t)tl * 8192;
                        unsigned a0 = (unsigned)((wc * 32 + 8 * fq + L) * 64 + 4 * (fr >> 3) + (((2 * ((fr >> 2) & 1)) ^ (2 * (fq & 1))) * 16));
                        asm volatile("" : "+v"(a0));
                        *(unsigned*)(tb + ((a0 ^ (unsigned)((m >> 1) * 16)) + 8 * (m & 1))) = w0;
                        *(unsigned*)(tb + ((a0 ^ (unsigned)(((m >> 1) ^ 1) * 16)) + 256 + 8 * (m & 1))) = w1;
                        continue;
                    }
                    u32x4 w; w.x = cvt_pk_bf16(v[0], v[1]); w.y = cvt_pk_bf16(v[2], v[3]); w.z = cvt_pk_bf16(v[4], v[5]); w.w = cvt_pk_bf16(v[6], v[7]);
                    *(u32x4*)(P + (size_t)R * NPJ + pcol + bj * 128) = w;
                }
            }
    }
};


namespace att {
constexpr int KSTR = 1040, KCOMP = 8 * KSTR, KBUF = 2 * KCOMP, VDB = 4160, VBUF = 4 * VDB, BUF = KBUF + VBUF;
constexpr int WSF_OFF = 2 * BUF;
__device__ __forceinline__ int crow(int r, int hi) { return (r & 3) + 8 * (r >> 2) + 4 * hi; }
__device__ __forceinline__ s16x4 vtr(LAS unsigned char* p) { typedef short v4i16_t __attribute__((ext_vector_type(4))); return __builtin_bit_cast(s16x4, __builtin_amdgcn_ds_read_tr16_b64_v4i16((LAS v4i16_t*)p)); }
#define MFMA32(a, b, c) __builtin_amdgcn_mfma_f32_32x32x16_bf16(a, b, c, 0, 0, 0)

}


namespace hg {
using att::vtr; using att::crow;
constexpr int COL_LF = 512, COL_V = 1536, COL_Q = 2048, COL_G = 2560;
constexpr int BS1 = 256 * 64;
constexpr int H1_K = 0, H1_V = 4 * BS1, H1_TOT = 8 * BS1;
#define HBAR() do { asm volatile("s_waitcnt lgkmcnt(0)" ::: "memory"); __builtin_amdgcn_s_barrier(); asm volatile("" ::: "memory"); } while (0)
__device__ __forceinline__ int seq_pos_to_sc(int dir, int p) { return (dir == 0 || p == 0) ? p : 33 - p; }

struct H1Regs { u32x16 lfa, lfb; u32x16 va, vb; };
__device__ __forceinline__ void h1_load(const bf16_t* P, int unit, int tid, H1Regs& R) {
    const int seq = unit >> 5, p = unit & 31, dir = seq & 1, h = (seq >> 1) & 3, b = seq >> 3;
    const int sc = seq_pos_to_sc(dir, p);
    const bf16_t* Pr = P + (size_t)(b * RB + sc * 256) * NPJ;
    const GAS char* bl = (const GAS char*)(Pr + COL_LF + dir * 512 + h * 128);
    unsigned off = (unsigned)(((tid >> 6) * 32) * NPJ + 2 * (tid & 63)) * 2u;
#pragma unroll
    for (int i = 0; i < 16; ++i) { R.lfa[i] = *(const GAS unsigned*)(bl + off); off += (unsigned)NPJ * 2u; asm volatile("" : "+v"(off)); }
#pragma unroll
    for (int i = 0; i < 16; ++i) { R.lfb[i] = *(const GAS unsigned*)(bl + off); off += (unsigned)NPJ * 2u; asm volatile("" : "+v"(off)); }
    const GAS char* bv = (const GAS char*)(Pr + COL_V + h * 128);
    unsigned voff = (unsigned)((tid >> 4) * NPJ + (tid & 15) * 8) * 2u;
#pragma unroll
    for (int i = 0; i < 4; ++i) { const u32x4 t_ = *(const GAS u32x4*)(bv + voff); R.va[4 * i] = t_.x; R.va[4 * i + 1] = t_.y; R.va[4 * i + 2] = t_.z; R.va[4 * i + 3] = t_.w; voff += 32u * (unsigned)NPJ * 2u; asm volatile("" : "+v"(voff)); }
#pragma unroll
    for (int i = 0; i < 4; ++i) { const u32x4 t_ = *(const GAS u32x4*)(bv + voff); R.vb[4 * i] = t_.x; R.vb[4 * i + 1] = t_.y; R.vb[4 * i + 2] = t_.z; R.vb[4 * i + 3] = t_.w; voff += 32u * (unsigned)NPJ * 2u; asm volatile("" : "+v"(voff)); }
}
__device__ __forceinline__ void h1_phase(LAS unsigned char* lds, const bf16_t* P, float* U, float* Dv, int first, int stride, int lim) {
    const int tid = opaque_tid(), lane = tid & 63, hh = lane >> 5, r32 = lane & 31; const int wid = __builtin_amdgcn_readfirstlane(tid >> 6);
    if (first >= lim) return;
    H1Regs R, Rn; h1_load(P, first, tid, R);
    if (first + stride < lim) h1_load(P, first + stride, tid, Rn);
#pragma unroll 1
    for (int unit = first; unit < lim; unit += stride) {
        const int dir = (unit >> 5) & 1;
#pragma unroll
        for (int i = 0; i < 8; ++i) { const int pc = tid + 512 * i, s = pc >> 4, j = pc & 15;
            const u32x4 t_ = i < 4 ? (u32x4){R.va[4 * i], R.va[4 * i + 1], R.va[4 * i + 2], R.va[4 * i + 3]} : (u32x4){R.vb[4 * (i - 4)], R.vb[4 * (i - 4) + 1], R.vb[4 * (i - 4) + 2], R.vb[4 * (i - 4) + 3]};
            *(LAS u32x4*)(lds + H1_V + (j >> 2) * BS1 + s * 64 + (j & 3) * 16) = t_; }
        const int k = 2 * (tid & 63), rg = tid >> 6;
#define H1_K2(LF, i) ((f32x2){__builtin_bit_cast(float, LF[i] << 16), __builtin_bit_cast(float, LF[i] & 0xffff0000u)})
        f32x2 tot2 = 1.f - H1_K2(R.lfa, 0);
#pragma unroll
        for (int i = 1; i < 16; ++i) tot2 *= 1.f - H1_K2(R.lfa, i);
#pragma unroll
        for (int i = 0; i < 16; ++i) tot2 *= 1.f - H1_K2(R.lfb, i);
        LAS float* totl = (LAS float*)(lds + H1_TOT);
        *(LAS f32x2*)(totl + rg * 128 + k) = tot2;
        asm volatile("" : "+v"(R.lfa), "+v"(R.lfb));
        HBAR();
        f32x2 all2 = {1.f, 1.f}, pre2 = {1.f, 1.f}, suf2 = {1.f, 1.f};
#pragma unroll
        for (int g = 0; g < 8; ++g) { const f32x2 tg = *(const LAS f32x2*)(totl + g * 128 + k); all2 *= tg; pre2 *= (g < rg) ? tg : (f32x2){1.f, 1.f}; suf2 *= (g > rg) ? tg : (f32x2){1.f, 1.f}; }
        LAS unsigned char* kimg = lds + H1_K + (k >> 5) * BS1 + (k & 31) * 2 + (rg * 32) * 64;
#define H1_ROW(LF, i, row) do { const f32x2 kk = H1_K2(LF, i); const f32x2 kw = kk * w; *(LAS unsigned*)(kimg + (row) * 64) = cvt_pk_bf16(kw.x, kw.y); w *= 1.f - kk; } while (0)
        if (dir == 0) { f32x2 w = suf2;
#pragma unroll
            for (int i = 15; i >= 0; --i) H1_ROW(R.lfb, i, 16 + i);
#pragma unroll
            for (int i = 15; i >= 0; --i) H1_ROW(R.lfa, i, i);
        } else { f32x2 w = pre2;
#pragma unroll
            for (int i = 0; i < 16; ++i) H1_ROW(R.lfa, i, i);
#pragma unroll
            for (int i = 0; i < 16; ++i) H1_ROW(R.lfb, i, 16 + i);
        }
#undef H1_ROW
#undef H1_K2
        if (rg == 0) *(f32x2*)(Dv + (size_t)unit * 128 + k) = all2;
        if (unit + stride < lim) { R = Rn; if (unit + 2 * stride < lim) h1_load(P, unit + 2 * stride, tid, Rn); }
        HBAR();
        const int vb = wid & 3, kb0 = 2 * (wid >> 2);
        const int trb = ((lane >> 4) & 1) * 32 + (lane & 3) * 8 + (8 * hh + ((lane & 15) >> 2)) * 64;
        f32x16 u0 = {}, u1 = {};
#pragma unroll 4
        for (int ks = 0; ks < 16; ++ks) {
            LAS unsigned char* vp = lds + H1_V + vb * BS1 + trb + ks * 1024; const s16x4 vl = vtr(vp), vh = vtr(vp + 256);
            const bf16x8 vf = {vl[0], vl[1], vl[2], vl[3], vh[0], vh[1], vh[2], vh[3]};
            LAS unsigned char* ap = lds + H1_K + kb0 * BS1 + trb + ks * 1024; const s16x4 al = vtr(ap), ah = vtr(ap + 256), bl = vtr(ap + BS1), bh = vtr(ap + BS1 + 256);
            const bf16x8 a0 = {al[0], al[1], al[2], al[3], ah[0], ah[1], ah[2], ah[3]}, a1 = {bl[0], bl[1], bl[2], bl[3], bh[0], bh[1], bh[2], bh[3]};
            u0 = MFMA32(a0, vf, u0); u1 = MFMA32(a1, vf, u1);
        }
#pragma unroll
        for (int g4 = 0; g4 < 4; ++g4) { GAS float* up0 = launder_g(U + (size_t)unit * 16384 + vb * 32 + r32 + (size_t)(kb0 * 32 + 8 * g4 + 4 * hh) * 128);
#pragma unroll
            for (int i = 0; i < 4; ++i) { up0[i * 128] = u0[4 * g4 + i]; up0[(32 + i) * 128] = u1[4 * g4 + i]; } }
        HBAR();
    }
}

__device__ __forceinline__ void scan_phase(float* U, const float* Dv, int seq, int e) {
    const int k = e >> 6, v = (e & 63) * 2;
    if (seq >= 16) return;
    f32x2 S = {0.f, 0.f};
    float* up = U + (size_t)seq * 32 * 16384 + k * 128 + v; const float* dp = Dv + (size_t)seq * 32 * 128 + k;
    f32x2 uu[32]; float dd[32];
#pragma unroll
    for (int p = 0; p < 32; ++p) { uu[p] = __builtin_nontemporal_load((const GAS f32x2*)(up + (size_t)p * 16384)); dd[p] = *(const GAS float*)(dp + p * 128); }
#pragma unroll
    for (int p = 0; p < 32; ++p) { S = S * dd[p] + uu[p]; *(GAS f32x2*)(up + (size_t)p * 16384) = S; }
}

constexpr int BS3 = 4160, PST = 144;
constexpr int D_Q = 0, D_K = 4 * BS3, D_V = 8 * BS3, D_P = 12 * BS3, D_TOT = D_P + 64 * PST, D_VEC = D_TOT + 2048, D_NP = D_VEC + 1536, DSZ = 65536;
static_assert(D_NP + 1024 + 256 <= DSZ, "H3 LDS block");

__device__ __forceinline__ void h3_load(const bf16_t* Pc, bool bwd, int h, int t4, u32x16& lfw, u32x16& qw, u32x16& vr) {
    const int k = 2 * (t4 & 63), rg = t4 >> 6;
    const GAS char* bl = (const GAS char*)(Pc + COL_LF + (bwd ? 512 : 0) + h * 128);
    const GAS char* bq = (const GAS char*)(Pc + COL_Q + h * 128);
    unsigned off = (unsigned)((rg * 16) * NPJ + k) * 2u;
#pragma unroll
    for (int i = 0; i < 16; ++i) { lfw[i] = *(const GAS unsigned*)(bl + off); qw[i] = *(const GAS unsigned*)(bq + off); off += (unsigned)NPJ * 2u; asm volatile("" : "+v"(off)); }
    const GAS char* bv = (const GAS char*)(Pc + COL_V + h * 128);
    unsigned voff = (unsigned)((t4 >> 4) * NPJ + (t4 & 15) * 8) * 2u;
#pragma unroll
    for (int i = 0; i < 4; ++i) { const u32x4 t_ = *(const GAS u32x4*)(bv + voff); vr[4 * i] = t_.x; vr[4 * i + 1] = t_.y; vr[4 * i + 2] = t_.z; vr[4 * i + 3] = t_.w; voff += 16u * (unsigned)NPJ * 2u; asm volatile("" : "+v"(voff)); }
}

__device__ __forceinline__ void h3_step(LAS unsigned char* L, bool bwd, const bf16_t* Pn, bool nbwd, int h, int t4_, int vb, int lane_,
                                        u32x16& lfw, u32x16& qw, u32x16& vr, f32x16 (&o)[2], f32x16 (&S)[4]) {
    int t4 = t4_, lane = lane_; asm volatile("" : "+v"(t4), "+v"(lane));
    const int hh = lane >> 5, r32 = lane & 31;
#pragma unroll
    for (int i = 0; i < 4; ++i) { const int pc = t4 + 256 * i, s = pc >> 4, j = pc & 15; *(LAS u32x4*)(L + D_V + (j >> 2) * BS3 + s * 64 + (j & 3) * 16) = (u32x4){vr[4 * i], vr[4 * i + 1], vr[4 * i + 2], vr[4 * i + 3]}; }
    const int k = 2 * (t4 & 63), rg = t4 >> 6;
#define H3_K2(i) ((f32x2){__builtin_bit_cast(float, lfw[i] << 16), __builtin_bit_cast(float, lfw[i] & 0xffff0000u)})
    f32x2 tot2 = 1.f - H3_K2(0);
#pragma unroll
    for (int i = 1; i < 16; ++i) tot2 *= 1.f - H3_K2(i);
    LAS float* totl = (LAS float*)(L + D_TOT);
    *(LAS f32x2*)(totl + rg * 128 + k) = tot2;
    HBAR();
    f32x2 all2 = {1.f, 1.f}, aft2 = {1.f, 1.f};
#pragma unroll
    for (int g = 0; g < 4; ++g) { const f32x2 tg = *(const LAS f32x2*)(totl + g * 128 + k);
        all2 *= tg;
        const bool after = bwd ? (g < rg) : (g > rg); aft2 *= after ? tg : (f32x2){1.f, 1.f}; }
    LAS unsigned char* qimg = L + D_Q + (k >> 5) * BS3 + (k & 31) * 2 + (rg * 16) * 64;
    LAS unsigned char* kimg = L + D_K + (k >> 5) * BS3 + (k & 31) * 2 + (rg * 16) * 64;
    f32x2 e = {__builtin_amdgcn_rcpf(tot2.x * aft2.x), __builtin_amdgcn_rcpf(tot2.y * aft2.y)}, inv = aft2;
#define H3_ROWQ(i) do { \
        const f32x2 qv = {__builtin_bit_cast(float, qw[i] << 16), __builtin_bit_cast(float, qw[i] & 0xffff0000u)}; \
        e *= 1.f - H3_K2(i); \
        const f32x2 qe = qv * e; *(LAS unsigned*)(qimg + (i) * 64) = cvt_pk_bf16(qe.x, qe.y); } while (0)
#define H3_ROWK(i) do { \
        const f32x2 kk = H3_K2(i); const f32x2 ke = kk * inv; inv *= 1.f - kk; \
        *(LAS unsigned*)(kimg + (i) * 64) = cvt_pk_bf16(ke.x, ke.y); } while (0)
    if (bwd) {
#pragma unroll
        for (int ii = 0; ii < 16; ++ii) { H3_ROWQ(15 - ii); H3_ROWK(ii); }
    } else {
#pragma unroll
        for (int ii = 0; ii < 16; ++ii) { H3_ROWQ(ii); H3_ROWK(15 - ii); }
    }
#undef H3_ROWQ
#undef H3_ROWK
#undef H3_K2
    LAS float* vec = (LAS float*)(L + D_VEC);
    if (rg == 0) *(LAS f32x2*)(vec + k) = all2;
    asm volatile("" ::: "memory");
    h3_load(Pn, nbwd, h, t4, lfw, qw, vr);
    HBAR();
#pragma unroll
    for (int kb = 0; kb < 4; ++kb)
#pragma unroll
        for (int g4 = 0; g4 < 4; ++g4) { const f32x4 d4 = *(const LAS f32x4*)(vec + kb * 32 + 8 * g4 + 4 * hh);
#pragma unroll
            for (int i = 0; i < 4; ++i) S[kb][4 * g4 + i] *= d4[i]; }
    {
        const int sb = vb & 1, rb = vb >> 1;
        f32x16 sc = {};
#pragma unroll
        for (int ks = 0; ks < 8; ++ks) { const int off = (ks >> 1) * BS3 + (ks & 1) * 32 + hh * 16;
            const bf16x8 a = *(const LAS bf16x8*)(L + D_K + off + (32 * sb + r32) * 64), bq = *(const LAS bf16x8*)(L + D_Q + off + (32 * rb + r32) * 64);
            sc = MFMA32(a, bq, sc); }
        const int rr = 32 * rb + r32;
        const int d0 = bwd ? (rr - 32 * sb - 4 * hh) : (32 * sb + 4 * hh - rr);
#pragma unroll
        for (int g = 0; g < 4; ++g) { const int s0 = 32 * sb + 8 * g + 4 * hh; float pv[4];
#pragma unroll
            for (int i = 0; i < 4; ++i) { const int cgi = 8 * g + i; const bool keep = d0 <= (bwd ? cgi : -cgi); pv[i] = keep ? sc[4 * g + i] : 0.f; }
            u32x2 w; w.x = cvt_pk_bf16(pv[0], pv[1]); w.y = cvt_pk_bf16(pv[2], pv[3]);
            *(LAS u32x2*)(L + D_P + rr * PST + s0 * 2) = w; }
    }
#pragma unroll
    for (int kb = 0; kb < 4; ++kb)
#pragma unroll
        for (int s = 0; s < 2; ++s) {
            u32x4 bw; bw.x = cvt_pk_bf16(S[kb][8 * s], S[kb][8 * s + 1]); bw.y = cvt_pk_bf16(S[kb][8 * s + 2], S[kb][8 * s + 3]); bw.z = cvt_pk_bf16(S[kb][8 * s + 4], S[kb][8 * s + 5]); bw.w = cvt_pk_bf16(S[kb][8 * s + 6], S[kb][8 * s + 7]);
            const bf16x8 bf = __builtin_bit_cast(bf16x8, bw);
#pragma unroll
            for (int rb = 0; rb < 2; ++rb) {
                LAS unsigned char* ap = L + D_Q + kb * BS3 + (32 * rb + r32) * 64 + (16 * s + 4 * hh) * 2;
                const u32x2 a0 = *(const LAS u32x2*)ap, a1 = *(const LAS u32x2*)(ap + 16);
                const u32x4 aw = {a0.x, a0.y, a1.x, a1.y};
                o[rb] = MFMA32(__builtin_bit_cast(bf16x8, aw), bf, o[rb]); }
        }
    HBAR();
    const int trb = ((lane >> 4) & 1) * 32 + (lane & 3) * 8 + (8 * hh + ((lane & 15) >> 2)) * 64;
    bf16x8 vf[4];
#pragma unroll
    for (int ks = 0; ks < 4; ++ks) { LAS unsigned char* vp = L + D_V + vb * BS3 + trb + ks * 1024; const s16x4 vl = vtr(vp), vh = vtr(vp + 256);
        vf[ks] = (bf16x8){vl[0], vl[1], vl[2], vl[3], vh[0], vh[1], vh[2], vh[3]}; }
#pragma unroll
    for (int rb = 0; rb < 2; ++rb)
#pragma unroll
        for (int ks = 0; ks < 4; ++ks) { const bf16x8 pa = *(const LAS bf16x8*)(L + D_P + (32 * rb + r32) * PST + ks * 32 + hh * 16); o[rb] = MFMA32(pa, vf[ks], o[rb]); }
#pragma unroll
    for (int kb = 0; kb < 4; ++kb)
#pragma unroll
        for (int ks = 0; ks < 4; ++ks) { LAS unsigned char* ap = L + D_K + kb * BS3 + trb + ks * 1024; const s16x4 al = vtr(ap), ah = vtr(ap + 256);
            const bf16x8 a0 = {al[0], al[1], al[2], al[3], ah[0], ah[1], ah[2], ah[3]}; S[kb] = MFMA32(a0, vf[ks], S[kb]); }
    HBAR();
}

__device__ __forceinline__ void h3_unit(LAS unsigned char* lds, const bf16_t* P, const float* U, bf16_t* mix, float* ofw  , const float* hg_norm, int unit) {
    const int tid = opaque_tid(), lane = tid & 63, hh = lane >> 5, r32 = lane & 31; const int wid = __builtin_amdgcn_readfirstlane(tid >> 6);
    const int dir = wid >> 2, vb = wid & 3, t4 = tid & 255;
    const bool bwd = dir != 0;
    const int sc = 1 + (unit & 31), h = (unit >> 5) & 3, b = unit >> 7;
    const bf16_t* Pr = P + (size_t)(b * RB + sc * 256) * NPJ;
    LAS unsigned char* L = lds + dir * DSZ;
    const GAS char* ofb = (const GAS char*)(ofw + (size_t)unit * 32768 + vb * 32);
    f32x16 S[4];
    { const float* Us = U + ((size_t)(((b * 4 + h) * 2 + dir) * 32 + (bwd ? 32 - sc : sc - 1))) * 16384 + vb * 32 + r32;
#pragma unroll
      for (int kb = 0; kb < 4; ++kb)
#pragma unroll
        for (int g4 = 0; g4 < 4; ++g4) { const GAS float* up = launder_g(Us + (size_t)(kb * 32 + 8 * g4 + 4 * hh) * 128);
#pragma unroll
            for (int i = 0; i < 4; ++i) S[kb][4 * g4 + i] = __builtin_nontemporal_load(up + i * 128); } }
    u32x16 lfw, qw, vr;
    h3_load(Pr + (size_t)(bwd ? 192 : 0) * NPJ, bwd, h, t4, lfw, qw, vr);
    const float gn = hg_norm[vb * 32 + r32];
    const int t0 = (sc - 1) * 256;
    LAS float* np = (LAS float*)(L + D_NP);
#pragma unroll 1
    for (int st = 0; st < 4; ++st) {
        const int c = bwd ? 3 - st : st, cn = st < 3 ? (bwd ? c - 1 : c + 1) : c;
        f32x16 o[2];
        if (st < 2) { o[0] = f32x16{}; o[1] = f32x16{}; }
        else {
#pragma unroll
            for (int rb = 0; rb < 2; ++rb)
#pragma unroll
                for (int g4 = 0; g4 < 4; ++g4) { unsigned oo = (unsigned)((64 * c + 4 * hh + 32 * rb + 8 * g4) * 128 + r32) * 4u; asm volatile("" : "+v"(oo));
#pragma unroll
                    for (int i = 0; i < 4; ++i) o[rb][4 * g4 + i] = *(const GAS float*)(ofb + oo + i * 512); }
        }
        h3_step(L, bwd, Pr + (size_t)(64 * cn) * NPJ, bwd, h, t4, vb, lane, lfw, qw, vr, o, S);
        if (st < 2) {
#pragma unroll
            for (int rb = 0; rb < 2; ++rb)
#pragma unroll
                for (int g4 = 0; g4 < 4; ++g4) { unsigned oo = (unsigned)((64 * c + 4 * hh + 32 * rb + 8 * g4) * 128 + r32) * 4u; asm volatile("" : "+v"(oo));
#pragma unroll
                    for (int i = 0; i < 4; ++i) *(GAS float*)((GAS char*)ofb + oo + i * 512) = o[rb][4 * g4 + i]; asm volatile("" ::: "memory"); }
            if (st == 1) { VM_WAIT(); HBAR(); }
        } else {
            {
                const bool b4 = (lane & 16) != 0, b3 = (lane & 8) != 0, b2 = (lane & 4) != 0, b1 = (lane & 2) != 0, b0 = (lane & 1) != 0;
#define H3_W16(k) ({ const float q0_ = o[0][k] * o[0][k], q1_ = o[1][k] * o[1][k]; const float keep_ = b4 ? q1_ : q0_, send_ = b4 ? q0_ : q1_; \
                     keep_ + __builtin_bit_cast(float, __builtin_amdgcn_ds_swizzle(__builtin_bit_cast(int, send_), 0x401F)); })
                float w8[8], w4[4], w2[2];
#pragma unroll
                for (int k = 0; k < 8; ++k) { const float lo_ = H3_W16(k), hi_ = H3_W16(k + 8); const float keep = b3 ? hi_ : lo_, send = b3 ? lo_ : hi_; w8[k] = keep + DPPF(send, 0x140); }
#undef H3_W16
#pragma unroll
                for (int k = 0; k < 4; ++k) { const float keep = b2 ? w8[k + 4] : w8[k], send = b2 ? w8[k] : w8[k + 4]; w4[k] = keep + DPPF(send, 0x141); }
#pragma unroll
                for (int k = 0; k < 2; ++k) { const float keep = b1 ? w4[k + 2] : w4[k], send = b1 ? w4[k] : w4[k + 2]; w2[k] = keep + DPPF(send, 0x4E); }
                const float tot = (b0 ? w2[1] : w2[0]) + DPPF(b0 ? w2[0] : w2[1], 0xB1);
                np[(32 * ((lane >> 4) & 1) + crow(lane & 15, hh)) * 4 + vb] = tot; }
            unsigned short gv[2][16];
            { const GAS char* bg = (const GAS char*)(Pr + COL_G + h * 128 + vb * 32);
              unsigned goff = (unsigned)((64 * c + 4 * hh) * NPJ + r32) * 2u;
#pragma unroll
              for (int rb = 0; rb < 2; ++rb)
#pragma unroll
                for (int g4 = 0; g4 < 4; ++g4)
#pragma unroll
                    for (int i = 0; i < 4; ++i) { gv[rb][4 * g4 + i] = *(const GAS unsigned short*)(bg + goff); goff += (unsigned)((i < 3 ? 1 : 5) * NPJ * 2); asm volatile("" : "+v"(goff)); } }
            HBAR();
            LAS float* rsl = np + 256;
            if (vb == 0) { const f32x4 q4 = *(const LAS f32x4*)(np + lane * 4); rsl[lane] = __builtin_amdgcn_rsqf(((q4.x + q4.y) + (q4.z + q4.w)) * (1.f / 128.f) + NORM_EPS); }
            HBAR();
#pragma unroll
            for (int rb = 0; rb < 2; ++rb)
#pragma unroll
                for (int g4 = 0; g4 < 4; ++g4) {
                    GAS unsigned char* mp = launder_g((unsigned char*)mix + (size_t)(b * SEQ + t0 + 64 * c + 4 * hh + 32 * rb + 8 * g4) * DM + 512 + h * 128 + vb * 32 + r32);
                    const f32x4 r4 = *(const LAS f32x4*)(rsl + 32 * rb + 8 * g4 + 4 * hh);
#pragma unroll
                    for (int i = 0; i < 4; ++i) { const int r = 4 * g4 + i;
                        const float ov = o[rb][r] * r4[i] * gn * bf2f(gv[rb][r]); mp[(size_t)i * DM] = fp8_1(ov); } }
        }
    }
    __syncthreads();
}
}


namespace att2 {
using att::crow; using att::vtr;
constexpr int KBUF = 8192, VBUF = 8192;
constexpr int LDS_K = 0, LDS_V = 5 * KBUF, LDS_WS = 65536;
constexpr int NT = RB / 64;
typedef int v8i_t __attribute__((ext_vector_type(8)));
#define SBAR() __builtin_amdgcn_sched_barrier(0)
#define PIN(x) asm volatile("" : "+v"(x))
#define WAIT_BAR(N) asm volatile("s_waitcnt vmcnt(" #N ") lgkmcnt(0)\n\ts_barrier" ::: "memory")
__device__ __forceinline__ void glds16(const void* g, unsigned lds_base) {
    asm volatile("s_mov_b32 m0, %1\n\ts_nop 0\n\tglobal_load_lds_dwordx4 %0, off" :: "v"(g), "s"(lds_base) : "memory", "m0"); }
__device__ __forceinline__ void glds16s(const void* sbase, unsigned voff, unsigned lds_base) {
    asm volatile("s_mov_b32 m0, %2\n\ts_nop 0\n\tglobal_load_lds_dwordx4 %0, %1" :: "v"(voff), "s"(sbase), "s"(lds_base) : "memory", "m0"); }
__device__ __forceinline__ unsigned cvtpk_s(float lo, float hi) { typedef __bf16 bf16x2_t __attribute__((ext_vector_type(2))); f32x2 v = {lo, hi}; bf16x2_t b = __builtin_convertvector(v, bf16x2_t); return __builtin_bit_cast(unsigned, b); }
__device__ __forceinline__ unsigned q8x4(unsigned w0, unsigned w1) {
    return cvt4_fp8_sat(__builtin_bit_cast(float, w0 << 16), __builtin_bit_cast(float, w0 & 0xffff0000u), __builtin_bit_cast(float, w1 << 16), __builtin_bit_cast(float, w1 & 0xffff0000u)); }

__device__ __forceinline__ void attn_prefetch(LAS unsigned char* lds, const unsigned char* KI, const unsigned char* VT, int b, int h) {
    const int tid = opaque_tid(), lane = tid & 63; const int wid = __builtin_amdgcn_readfirstlane(tid >> 6);
    const unsigned lds0 = (unsigned)(size_t)lds, loff = (unsigned)lane * 16u;
    const unsigned char* ksrc = KI + (size_t)((b * 4 + h) * 132) * 8192 + wid * 1024;
    const unsigned char* vsrc = VT + (size_t)((b * 4 + h) * 132) * 8192 + wid * 1024;
    const unsigned kdst = (unsigned)__builtin_amdgcn_readfirstlane(lds0 + LDS_K + wid * 1024), vdst = (unsigned)__builtin_amdgcn_readfirstlane(lds0 + LDS_V + wid * 1024);
#pragma unroll
    for (int t = 0; t < 3; ++t) glds16s(ksrc + (size_t)t * 8192, loff, kdst + t * KBUF);
    glds16s(vsrc, loff, vdst);
}
__device__ __forceinline__ void attn_unit(LAS unsigned char* lds, const bf16_t* P, const unsigned char* KI, const unsigned char* VT, bf16_t* mix, int b, int h, int qb, float lam, const float* subln) {
    const int tid = opaque_tid(), lane = tid & 63, r32 = lane & 31, hh = lane >> 5; const int wid = __builtin_amdgcn_readfirstlane(tid >> 6);
    const int comp = wid >> 2, rbk = wid & 3;
    const bf16_t* Pb = P + (size_t)b * RB * NPJ;
    const unsigned lds0 = (unsigned)(size_t)lds;
    const unsigned char* ksrc = KI + (size_t)((b * 4 + h) * 132) * 8192 + wid * 1024;
    const unsigned char* vsrc = VT + (size_t)((b * 4 + h) * 132) * 8192 + wid * 1024;
    const unsigned loff = (unsigned)lane * 16u;
    const unsigned kdst = lds0 + LDS_K + wid * 1024, vdst = lds0 + LDS_V + wid * 1024;
#define DMA_K(t, slot) glds16s(ksrc + (size_t)(t) * 8192, loff, (unsigned)__builtin_amdgcn_readfirstlane(kdst + (slot)))
#define DMA_V(t, slot) glds16s(vsrc + (size_t)(t) * 8192, loff, (unsigned)__builtin_amdgcn_readfirstlane(vdst + (slot)))
    const int qrow = CTXL + qb * 128 + rbk * 32 + r32;
    const u32x4* qp = (const u32x4*)(Pb + (size_t)qrow * NPJ + h * 128 + comp * 64 + hh * 32);
    const u32x4 q0 = qp[0], q1 = qp[1], q2 = qp[2], q3 = qp[3];
    DMA_K(0, 0); DMA_V(0, 0); DMA_K(1, KBUF); DMA_K(2, 2 * KBUF); DMA_K(3, 3 * KBUF); DMA_V(1, VBUF);
    const v8i_t qf = {(int)q8x4(q0.x, q0.y), (int)q8x4(q0.z, q0.w), (int)q8x4(q1.x, q1.y), (int)q8x4(q1.z, q1.w), (int)q8x4(q2.x, q2.y), (int)q8x4(q2.z, q2.w), (int)q8x4(q3.x, q3.y), (int)q8x4(q3.z, q3.w)};
    const int sw = (r32 >> 2) & 3;
    LAS unsigned char* kpa = lds + LDS_K + comp * 4096 + r32 * 64 + (((2 * hh) ^ sw) * 16);
    LAS unsigned char* kpb = lds + LDS_K + comp * 4096 + r32 * 64 + (((2 * hh + 1) ^ sw) * 16);
    LAS unsigned char* vpa = lds + LDS_V + r32 * 64 + (((2 * hh) ^ sw) * 16);
    LAS unsigned char* vpb = lds + LDS_V + r32 * 64 + (((2 * hh + 1) ^ sw) * 16);
    int kpv = 4 * KBUF, kc = 0, kn = KBUF, kn2 = 2 * KBUF, kn3 = 3 * KBUF;
    int vfr = 2 * VBUF, vp = 3 * VBUF, vc = 0, vn = VBUF;
#define ROT() do { const int a_ = kpv; kpv = kc; kc = kn; kn = kn2; kn2 = kn3; kn3 = a_; const int b_ = vfr; vfr = vp; vp = vc; vc = vn; vn = b_; } while (0)
#define V8(x, y) (v8i_t){(int)x[0], (int)x[1], (int)x[2], (int)x[3], (int)y[0], (int)y[1], (int)y[2], (int)y[3]}
#define LDK(X, Y, slot, kb) do { X = *(const LAS u32x4*)(kpa + (slot) + (kb) * 2048); Y = *(const LAS u32x4*)(kpb + (slot) + (kb) * 2048); } while (0)
#define MFMA8(a, bv, c) __builtin_amdgcn_mfma_scale_f32_32x32x64_f8f6f4(a, bv, c, 0, 0, 0, 0, 0, 0)
#define MFMAQK(a, c) __builtin_amdgcn_mfma_scale_f32_32x32x64_f8f6f4(a, qf, c, 0, 0, 0, 0, 0, 0)
    f32x16 o[4]; o[0] = f32x16{}; o[1] = f32x16{}; o[2] = f32x16{}; o[3] = f32x16{};
    f32x16 osum = {};
    const v8i_t ones = {0x38383838, 0x38383838, 0x38383838, 0x38383838, 0x38383838, 0x38383838, 0x38383838, 0x38383838};
    f32x16 negm, pA0, pA1, pB0, pB1;
    WAIT_BAR(4);
    {
        u32x4 a0, a1, b0, b1; LDK(a0, a1, kc, 0); LDK(b0, b1, kc, 1);
        f32x16 s0 = {}, s1 = {};
        s0 = MFMAQK(V8(a0, a1), s0); s1 = MFMAQK(V8(b0, b1), s1);
        float m = fmaxf(s0[0], s1[0]);
#pragma unroll
        for (int r = 1; r < 16; ++r) m = fmaxf(m, fmaxf(s0[r], s1[r]));
        m = fmaxf(m, __shfl_xor(m, 32)) + 2.f;
#pragma unroll
        for (int r = 0; r < 16; ++r) { negm[r] = -m; pA0[r] = __builtin_amdgcn_exp2f(s0[r] - m); pA1[r] = __builtin_amdgcn_exp2f(s1[r] - m); }
        asm volatile("" : "+v"(negm));
        WAIT_BAR(0);
        ROT();
    }
    u32x4 kfa, kfb;
    LDK(kfa, kfb, kc, 0);
    u32x4 pwl = {0u, 0u, 0u, 0u}, pwh = {0u, 0u, 0u, 0u};
    if (wid >= 4) __builtin_amdgcn_s_setprio(1);
#define PK8(W, I, Pv, B) do { int t_ = __builtin_amdgcn_cvt_pk_fp8_f32(Pv[B], Pv[(B) + 1], (int)W[I], false); W[I] = (unsigned)__builtin_amdgcn_cvt_pk_fp8_f32(Pv[(B) + 2], Pv[(B) + 3], t_, true); } while (0)
#define VLD(j) do { vfa[j] = *(const LAS u32x4*)(vqa + (j) * 2048); vfb[j] = *(const LAS u32x4*)(vqb + (j) * 2048); } while (0)
#define GAPA(Cx, KA, KB, Pv, W, EXTRA) do { EXTRA; Cx = MFMAQK(V8(KA, KB), negm); PIN(Cx); \
        PK8(W, 0, Pv, 0); PK8(W, 1, Pv, 4); PK8(W, 2, Pv, 8); PK8(W, 3, Pv, 12); PIN(W); SBAR(); } while (0)
#define EX2(X, B) do { X[B] = __builtin_amdgcn_exp2f(X[B]); X[(B) + 1] = __builtin_amdgcn_exp2f(X[(B) + 1]); } while (0)
#define GAPB(j, X, B, EXTRA) do { if ((j) + 2 < 4) VLD((j) + 2); EXTRA; o[j] = MFMA8(V8(pwl, pwh), V8(vfa[j], vfb[j]), o[j]); PIN(o[j]); \
        EX2(X, B); EX2(X, (B) + 2); EX2(X, (B) + 4); EX2(X, (B) + 6); PIN(X); SBAR(); } while (0)
#define STEP(C0, C1, P0, P1, t, GK, GV, PRE) do { SBAR(); \
        LAS unsigned char* vqa = vpa + vp; LAS unsigned char* vqb = vpb + vp; \
        u32x4 kga, kgb, vfa[4], vfb[4]; \
        GAPA(C0, kfa, kfb, P0, pwl, { LDK(kga, kgb, kc, 1); VLD(0); }); \
        GAPA(C1, kga, kgb, P1, pwh, VLD(1)); \
        GAPB(0, C0, 0, if (GK) { DMA_K((t) + 3, kn3); DMA_K((t) + 4, kpv); }); \
        GAPB(1, C0, 8, if (GV) { DMA_V((t) + 1, vn); DMA_V((t) + 2, vfr); }); \
        GAPB(2, C1, 0, { if (PRE) LDK(kfa, kfb, kn, 0); osum = MFMA8(V8(pwl, pwh), ones, osum); PIN(osum); }); \
        GAPB(3, C1, 8, (void)0); \
    } while (0)
#pragma unroll 1
    for (int t = 1; t <= NT - 5; t += 2) {
        STEP(pB0, pB1, pA0, pA1, t, true, true, true);        ROT();
        STEP(pA0, pA1, pB0, pB1, t + 1, false, false, true);  WAIT_BAR(0); ROT();
    }
    STEP(pB0, pB1, pA0, pA1, NT - 3, false, true, true);   ROT();
    STEP(pA0, pA1, pB0, pB1, NT - 2, false, false, true);  WAIT_BAR(0); ROT();
    STEP(pB0, pB1, pA0, pA1, NT - 1, false, false, false); WAIT_BAR(0); ROT();
    {
#pragma unroll
        for (int i = 0; i < 4; ++i) { PK8(pwl, i, pB0, 4 * i); PK8(pwh, i, pB1, 4 * i); }
        osum = MFMA8(V8(pwl, pwh), ones, osum);
        LAS unsigned char* vqa = vpa + vp; LAS unsigned char* vqb = vpb + vp;
#pragma unroll
        for (int j = 0; j < 4; ++j) { const u32x4 va = *(const LAS u32x4*)(vqa + j * 2048), vb = *(const LAS u32x4*)(vqb + j * 2048);
            o[j] = MFMA8(V8(pwl, pwh), V8(va, vb), o[j]); PIN(o[j]); }
    }
    __builtin_amdgcn_s_setprio(0);
    __syncthreads();
    LAS float* X = (LAS float*)lds + rbk * 4096;
    const float cmul = comp ? lam : 1.f;
#pragma unroll
    for (int r = 0; r < 16; ++r) { const float sc = cmul * __builtin_amdgcn_rcpf(osum[r]);
#pragma unroll
        for (int db = 0; db < 4; ++db) o[db][r] *= sc; }
    if (comp == 1) {
#pragma unroll
        for (int db = 0; db < 4; ++db)
#pragma unroll
            for (int r = 0; r < 16; ++r) X[(db * 16 + r) * 64 + lane] = o[db][r];
    }
    __syncthreads();
    if (comp == 0) {
        float sl[4];
#pragma unroll
        for (int db = 0; db < 4; ++db) sl[db] = subln[db * 32 + r32] * (1.f - LAMBDA_INIT);
        unsigned char* orow = (unsigned char*)mix + (size_t)(b * SEQ + qb * 128 + rbk * 32 + 4 * hh) * DM + h * 128 + r32;
#pragma unroll
        for (int r = 0; r < 16; ++r) {
            float ss = 0.f;
#pragma unroll
            for (int db = 0; db < 4; ++db) { o[db][r] -= X[(db * 16 + r) * 64 + lane]; ss += o[db][r] * o[db][r]; }
            ss = half_sum32(ss);
            const float rstd = __builtin_amdgcn_rsqf(ss * (1.f / 128.f) + NORM_EPS);
#pragma unroll
            for (int db = 0; db < 4; ++db) orow[(size_t)((r & 3) + 8 * (r >> 2)) * DM + db * 32] = fp8_1(o[db][r] * rstd * sl[db]);
        }
    }
    __syncthreads();
#undef DMA_K
#undef DMA_V
#undef ROT
#undef LDK
#undef MFMA8
#undef MFMAQK
#undef PK8
#undef VLD
#undef V8
#undef EX2
#undef GAPA
#undef GAPB
#undef STEP
}
#undef SBAR
#undef PIN
#undef WAIT_BAR
}

struct SchedPlain {
    int nM, nN, nwg, G, c; const bf16_t* Bt; int K;
    __device__ bool next(int i, pg8::Unit& u) const {
        const long L = (long)i * G + c; if (L >= nwg) return false;
        int wgid = (int)L; { const int q = nwg / 8, r = nwg % 8, xcd = wgid % 8, off = wgid / 8; wgid = (xcd < r ? xcd * (q + 1) : r * (q + 1) + (xcd - r) * q) + off; }
        const int nig = 8 * nN, gid = wgid / nig, fm = gid * 8, gsz = (nM - fm) < 8 ? (nM - fm) : 8;
        u.pm = fm + ((wgid % nig) % gsz); u.pn = (wgid % nig) / gsz; u.arow0 = u.pm * 256; u.gadd = 0; u.gidx = nullptr; u.Bt = Bt + (size_t)u.pn * 256 * K; u.aux = 0; return true;
    }
};
struct EpiYbf16 {
    static constexpr bool PERM = true;
    bf16_t* O; int ldc;
    __device__ __forceinline__ void operator()(const f32x4 (&acc)[2][2][4][2], const pg8::Unit& u, int wr, int wc, int fr, int fq) const {
#pragma unroll
        for (int ai = 0; ai < 2; ++ai)
#pragma unroll
            for (int m = 0; m < 4; ++m) { bf16_t* rowp = O + (size_t)(u.pm * 256 + ai * 128 + wr * 64 + m * 16 + fr) * ldc + u.pn * 256 + wc * 32 + 8 * fq;
#pragma unroll
                for (int bj = 0; bj < 2; ++bj) { const f32x4 v0 = acc[ai][bj][m][0] * W8_INV, v1 = acc[ai][bj][m][1] * W8_INV;
                    u32x4 w; w.x = cvt_pk_bf16(v0[0], v0[1]); w.y = cvt_pk_bf16(v0[2], v0[3]); w.z = cvt_pk_bf16(v1[0], v1[1]); w.w = cvt_pk_bf16(v1[2], v1[3]);
                    *(u32x4*)(rowp + bj * 128) = w; } }
    }
};

struct P7Rows { f32x4 xvn[2][4]; };
__device__ __forceinline__ void p7_pre(Frame& F, const Args& a, P7Rows& st) {
    const int tid_ = opaque_tid();
    {
        const int lane_ = tid_ & 63; const int gw = F.p7_gw, NGW = F.p7_ngw, LIM = F.p7_lim;
        if (gw < LIM) { const int m1 = gw + NGW < LIM ? gw + NGW : gw; const GAS f32x4* x0 = (const GAS f32x4*)(a.x + (size_t)gw * DM) + lane_; const GAS f32x4* x1 = (const GAS f32x4*)(a.x + (size_t)m1 * DM) + lane_;
#pragma unroll
            for (int j = 0; j < 4; ++j) { st.xvn[0][j] = __builtin_nontemporal_load(x0 + 64 * j); st.xvn[1][j] = __builtin_nontemporal_load(x1 + 64 * j); } } }
    LAS float* par = (LAS float*)F.lds;
    LAS float* wrT = (LAS float*)(F.lds + 24576);
    const float* mod = (const float*)(a.ws + WS_MOD);
    for (int i = tid_; i < 2048; i += 512) { const int b = i >> 10, c = i & 1023;
        par[b * 3072 + c] = mod[b * 6144 + 2048 + c] * a.n_post_mix[c]; par[b * 3072 + 1024 + c] = a.n_pre_ffn[c] * (1.f + mod[b * 6144 + 4096 + c]); par[b * 3072 + 2048 + c] = mod[b * 6144 + 3072 + c]; }
    for (int i = tid_; i < 16384; i += 512) { const int c = i >> 4, e = i & 15; wrT[e * 1024 + c] = a.w_router[i]; }
}
__device__ __forceinline__ void p7_rowpass(Frame& F, const Args& a, P7Rows& st) {
    const int tid_ = opaque_tid(), lane_ = tid_ & 63; const int wave_ = __builtin_amdgcn_readfirstlane(tid_ >> 6);
    LAS float* par = (LAS float*)F.lds; LAS float* wrT = (LAS float*)(F.lds + 24576);
    __syncthreads();
    const bf16_t* ylat = (const bf16_t*)(a.ws + WS_YLAT); unsigned char* h2 = a.ws + WS_H2; float* aff = (float*)(a.ws + WS_AFF);
    const int gw = F.p7_gw, NGW = F.p7_ngw, LIM = F.p7_lim;
    u32x2 ywn[2][4]; f32x4 (&xvn)[2][4] = st.xvn;
#define P7_LOADY(m0_) do { const bool v1_ = (m0_) + NGW < LIM; const int mm_[2] = {(m0_), v1_ ? (m0_) + NGW : (m0_)}; \
        _Pragma("unroll") for (int u = 0; u < 2; ++u) { const GAS u32x2* yr = (const GAS u32x2*)(ylat + (size_t)mm_[u] * DM) + lane_; \
            _Pragma("unroll") for (int j = 0; j < 4; ++j) ywn[u][j] = yr[64 * j]; } } while (0)
#define P7_LOAD(m0_) do { const bool v1_ = (m0_) + NGW < LIM; const int mm_[2] = {(m0_), v1_ ? (m0_) + NGW : (m0_)}; \
        _Pragma("unroll") for (int u = 0; u < 2; ++u) { const GAS u32x2* yr = (const GAS u32x2*)(ylat + (size_t)mm_[u] * DM) + lane_; const GAS f32x4* xr = (const GAS f32x4*)(a.x + (size_t)mm_[u] * DM) + lane_; \
            _Pragma("unroll") for (int j = 0; j < 4; ++j) { ywn[u][j] = yr[64 * j]; xvn[u][j] = __builtin_nontemporal_load(xr + 64 * j); } } } while (0)
    if (gw < LIM) P7_LOADY(gw);
    for (int m0 = gw; m0 < LIM; m0 += 2 * NGW) {
        const bool v1 = m0 + NGW < LIM; const int mm[2] = {m0, v1 ? m0 + NGW : m0};
        f32x4 yv[2][4], xv[2][4]; float ss[2] = {0.f, 0.f};
#pragma unroll
        for (int u = 0; u < 2; ++u)
#pragma unroll
            for (int j = 0; j < 4; ++j) { const u32x2 w = ywn[u][j]; yv[u][j] = (f32x4){__builtin_bit_cast(float, w.x << 16), __builtin_bit_cast(float, w.x & 0xffff0000u), __builtin_bit_cast(float, w.y << 16), __builtin_bit_cast(float, w.y & 0xffff0000u)}; xv[u][j] = xvn[u][j]; }
        if (m0 + 2 * NGW < LIM) P7_LOAD(m0 + 2 * NGW);
#pragma unroll
        for (int u = 0; u < 2; ++u)
#pragma unroll
            for (int j = 0; j < 4; ++j) ss[u] += (yv[u][j].x * yv[u][j].x + yv[u][j].y * yv[u][j].y) + (yv[u][j].z * yv[u][j].z + yv[u][j].w * yv[u][j].w);
        ss[0] = wave_sum(ss[0]); ss[1] = wave_sum(ss[1]);
        float ss2[2] = {0.f, 0.f};
#pragma unroll
        for (int u = 0; u < 2; ++u) { const int b = mm[u] >> 13; const float rstd = __builtin_amdgcn_rsqf(ss[u] * (1.f / DM) + NORM_EPS);
            GAS unsigned long long* orow = (GAS unsigned long long*)((bf16_t*)(a.ws + WS_X1B) + (size_t)mm[u] * DM) + lane_;
#pragma unroll
            for (int j = 0; j < 4; ++j) { const int c = 4 * lane_ + 256 * j; const f32x4 a1 = *(const LAS f32x4*)(par + b * 3072 + c);
                xv[u][j] = xv[u][j] + a1 * (yv[u][j] * rstd); if (u == 0 || v1) orow[64 * j] = (unsigned long long)cvt_pk_bf16(xv[u][j].x, xv[u][j].y) | ((unsigned long long)cvt_pk_bf16(xv[u][j].z, xv[u][j].w) << 32);
                ss2[u] += (xv[u][j].x * xv[u][j].x + xv[u][j].y * xv[u][j].y) + (xv[u][j].z * xv[u][j].z + xv[u][j].w * xv[u][j].w); } }
        ss2[0] = wave_sum(ss2[0]); ss2[1] = wave_sum(ss2[1]);
#pragma unroll
        for (int u = 0; u < 2; ++u) { if (u == 1 && !v1) break;
            const int m = mm[u], b = m >> 13, t = m & 8191;
            const float rstd2 = __builtin_amdgcn_rsqf(ss2[u] * (1.f / DM) + NORM_EPS);
            GAS unsigned* o8 = (GAS unsigned*)(h2 + (size_t)m * DM) + lane_;
            f32x2 lg2[16];
#pragma unroll
            for (int e = 0; e < 16; ++e) lg2[e] = (f32x2){0.f, 0.f};
#pragma unroll
            for (int j = 0; j < 4; ++j) { const int c = 4 * lane_ + 256 * j; const f32x4 a2 = *(const LAS f32x4*)(par + b * 3072 + 1024 + c), a3 = *(const LAS f32x4*)(par + b * 3072 + 2048 + c);
                const f32x4 hv = xv[u][j] * rstd2 * a2 + a3;
                { float h0 = hv.x, h1 = hv.y, h2_ = hv.z, h3 = hv.w; asm volatile("" : "+v"(h0), "+v"(h1), "+v"(h2_), "+v"(h3)); o8[64 * j] = cvt4_fp8_sat(h0, h1, h2_, h3); }
                const f32x2 hlo = {hv.x, hv.y}, hhi = {hv.z, hv.w};
#pragma unroll
                for (int e = 0; e < 16; ++e) { const f32x4 w = *(const LAS f32x4*)(wrT + e * 1024 + c); lg2[e] = __builtin_elementwise_fma(hlo, (f32x2){w.x, w.y}, lg2[e]); lg2[e] = __builtin_elementwise_fma(hhi, (f32x2){w.z, w.w}, lg2[e]); } }
            float lg[16];
#pragma unroll
            for (int e = 0; e < 16; ++e) lg[e] = lg2[e].x + lg2[e].y;
            const float lgt = reduce16(lg, lane_);
            const float mx = row_max16(lgt), pe = __expf(lgt - mx), den = row_sum16(pe);
            if (lane_ < 16) aff[(size_t)(b * 16 + lane_) * SEQ + t] = pe / den;
            __builtin_amdgcn_sched_barrier(0); }
    }
#undef P7_LOAD
#undef P7_LOADY
    __syncthreads();
}


__device__ __forceinline__ void topk_unit(LAS unsigned char* lds, const float* aff, int* sel_idx, float* sel_gate, short* slot_map, int be) {
    const int tid = opaque_tid(), lane = tid & 63; const int wid = __builtin_amdgcn_readfirstlane(tid >> 6);
    const int b = be >> 4, e = be & 15;
    LAS unsigned* ctl = (LAS unsigned*)(lds + 1024);
    const float* ap = aff + (size_t)be * SEQ + tid * 16;
    unsigned key[16];
#pragma unroll
    for (int j = 0; j < 4; ++j) { const u32x4 v = *(const u32x4*)(ap + 4 * j); key[4 * j] = v.x; key[4 * j + 1] = v.y; key[4 * j + 2] = v.z; key[4 * j + 3] = v.w; }
    unsigned prefix = 0u;
#pragma unroll 1
    for (int bit = 30; bit >= 0; --bit) {
        const unsigned cand = prefix | (1u << bit);
        unsigned c = 0u;
#pragma unroll
        for (int i = 0; i < 16; ++i) c += (unsigned)__builtin_popcountll(__builtin_amdgcn_ballot_w64(key[i] >= cand));
        LAS unsigned* bank = ctl + (bit & 1) * 8;
        if (lane == 0) bank[wid] = c;
        __syncthreads();
        unsigned tot = 0u;
#pragma unroll
        for (int w = 0; w < 8; ++w) tot += bank[w];
        if (tot >= (unsigned)CAP) prefix = cand;
    }
    unsigned need;
    {
        unsigned c = 0u;
#pragma unroll
        for (int i = 0; i < 16; ++i) c += key[i] > prefix ? 1u : 0u;
        c = wave_sum_u(c);
        __syncthreads();
        if (lane == 0) ctl[wid] = c;
        __syncthreads();
        unsigned tot = 0u;
#pragma unroll
        for (int w = 0; w < 8; ++w) tot += ctl[w];
        need = (unsigned)CAP - tot;
        __syncthreads();
    }
    const unsigned T = prefix;
    unsigned cg = 0u, ce = 0u;
#pragma unroll
    for (int i = 0; i < 16; ++i) { cg += key[i] > T ? 1u : 0u; ce += key[i] == T ? 1u : 0u; }
    unsigned pk = cg | (ce << 16), inc = pk;
#pragma unroll
    for (int o = 1; o < 64; o <<= 1) { const unsigned n = __shfl_up(inc, o); if (lane >= o) inc += n; }
    if (lane == 63) ctl[16 + wid] = inc;
    __syncthreads();
    unsigned wbase = 0u;
#pragma unroll
    for (int w = 0; w < 8; ++w) if (w < wid) wbase += ctl[16 + w];
    const unsigned excl = wbase + inc - pk;
    unsigned sg = excl & 0xffffu, se = excl >> 16;
    const unsigned total_gt = CAP - need;
    int* si = sel_idx + (size_t)be * CAP; float* sgp = sel_gate + (size_t)be * CAP; short* sm = slot_map + ((size_t)b * SEQ + tid * 16) * 16 + e;
#pragma unroll
    for (int i = 0; i < 16; ++i) {
        int slot = -1;
        if (key[i] > T) { slot = (int)sg; ++sg; }
        else if (key[i] == T) { if (se < need) slot = (int)(total_gt + se); ++se; }
        if (slot >= 0) { si[slot] = tid * 16 + i; sgp[slot] = __builtin_bit_cast(float, key[i]); }
        sm[i * 16] = (short)slot;
    }
    __syncthreads();
}

struct SchedMoe1 {
    int c; const bf16_t* Wgu; const int* sel_idx;
    __device__ bool next(int i, pg8::Unit& u) const {
        if (i >= 4) return false;
        const int x = c & 7, j = c >> 3, ui = i * 32 + j, e = x + 8 * (ui >> 6), rem = ui & 63, b = rem >> 5, mt = (rem >> 3) & 3, pn = rem & 7;
        u.pm = (b * 16 + e) * 4 + mt; u.pn = pn; u.arow0 = 0; u.gadd = b * SEQ; u.gidx = sel_idx + (size_t)(b * 16 + e) * CAP + mt * 256;
        u.Bt = (const bf16_t*)((const unsigned char*)Wgu + (size_t)e * 2097152 + (size_t)pn * 256 * 1024); u.aux = 0; return true;
    }
};
struct EpiSwiglu {
    static constexpr bool PERM = true;
    unsigned char* H;
    __device__ __forceinline__ void operator()(const f32x4 (&acc)[2][2][4][2], const pg8::Unit& u, int wr, int wc, int fr, int fq) const {
#pragma unroll
        for (int ai = 0; ai < 2; ++ai)
#pragma unroll
            for (int m = 0; m < 4; ++m) { unsigned char* rowp = H + (size_t)(u.pm * 256 + ai * 128 + wr * 64 + m * 16 + fr) * FFD + u.pn * 128 + wc * 32 + 8 * fq;
                float hv[8];
#pragma unroll
                for (int n = 0; n < 2; ++n)
#pragma unroll
                    for (int i = 0; i < 4; ++i) { const float ag = acc[ai][0][m][n][i], au = acc[ai][1][m][n][i];
                        hv[4 * n + i] = (ag * au) * __builtin_amdgcn_rcpf(1024.f + __builtin_amdgcn_exp2f(ag * (-W8_INV * 1.4426950408889634f) + 10.f)); }
                u32x2 w; w.x = cvt4_fp8_sat(hv[0], hv[1], hv[2], hv[3]); w.y = cvt4_fp8_sat(hv[4], hv[5], hv[6], hv[7]);
                *(u32x2*)rowp = w; }
    }
};
struct SchedMoe2 {
    int c; const bf16_t* Wd;
    __device__ bool next(int i, pg8::Unit& u) const {
        if (i >= 2) return false;
        const int x = c & 7, j = c >> 3, e = x + 8 * i, b = j >> 4, mt = (j >> 2) & 3, pn = j & 3;
        u.pm = (b * 16 + e) * 4 + mt; u.pn = pn; u.arow0 = u.pm * 256; u.gadd = 0; u.gidx = nullptr;
        u.Bt = (const bf16_t*)((const unsigned char*)Wd + (size_t)e * 1048576 + (size_t)pn * 256 * 1024); u.aux = 0; return true;
    }
};
constexpr float Y8_SCALE = 16.f;
struct EpiGateBf16 {
    static constexpr bool PERM = true;
    unsigned char* Y; const float* gate;
    __device__ __forceinline__ void operator()(const f32x4 (&acc)[2][2][4][2], const pg8::Unit& u, int wr, int wc, int fr, int fq) const {
#pragma unroll
        for (int ai = 0; ai < 2; ++ai)
#pragma unroll
            for (int m = 0; m < 4; ++m) { const int row = u.pm * 256 + ai * 128 + wr * 64 + m * 16 + fr; const float gt = gate[row];
                unsigned char* rowp = Y + (size_t)row * DM + u.pn * 256 + wc * 32 + 8 * fq;
#pragma unroll
                for (int bj = 0; bj < 2; ++bj) { const f32x4 v0 = acc[ai][bj][m][0] * (gt * (W8_INV * Y8_SCALE)), v1 = acc[ai][bj][m][1] * (gt * (W8_INV * Y8_SCALE));
                    u32x2 w; w.x = cvt4_fp8_sat(v0[0], v0[1], v0[2], v0[3]); w.y = cvt4_fp8_sat(v1[0], v1[1], v1[2], v1[3]);
                    *(u32x2*)(rowp + bj * 128) = w; } }
    }
};

struct P11Rows { u32x2 xw[2][4]; u32x4 s0[2], s1[2]; };
__device__ __forceinline__ void p11_load(const Args& a, int m0, int NGW, int lane, P11Rows& st) {
    const int mm[2] = {m0, m0 + NGW < ML ? m0 + NGW : m0}; const short* slot_map = (const short*)(a.ws + WS_SLOT);
#pragma unroll
    for (int u = 0; u < 2; ++u) { st.s0[u] = *(const u32x4*)(slot_map + (size_t)mm[u] * 16); st.s1[u] = *(const u32x4*)(slot_map + (size_t)mm[u] * 16 + 8);
        const GAS u32x2* xr = (const GAS u32x2*)((const bf16_t*)(a.ws + WS_X1B) + (size_t)mm[u] * DM) + lane;
#pragma unroll
        for (int j = 0; j < 4; ++j) st.xw[u][j] = xr[64 * j]; }
}
__device__ __forceinline__ void p11_pre(Frame& F, const Args& a, P11Rows& st) {
    const int tid = opaque_tid();
    { const int lane = tid & 63; const int wave = __builtin_amdgcn_readfirstlane(tid >> 6); const int gw = F.vcu * NWAVES + wave; if (gw < ML) p11_load(a, gw, F.G * NWAVES, lane, st); }
    LAS float* par = (LAS float*)F.lds;
    const float* mod = (const float*)(a.ws + WS_MOD);
    for (int i = tid; i < 2048; i += 512) { const int b = i >> 10, c = i & 1023; par[i] = mod[b * 6144 + 5120 + c] * a.n_post_ffn[c]; }
}
__device__ __forceinline__ void p11_combine(Frame& F, const Args& a, P11Rows& st) {
    const int tid = opaque_tid(), lane = tid & 63; const int wave = __builtin_amdgcn_readfirstlane(tid >> 6);
    LAS float* par = (LAS float*)F.lds;
    __syncthreads();
    const unsigned char* ye = a.ws + WS_YE; const short* slot_map = (const short*)(a.ws + WS_SLOT);
    const int gw = F.vcu * NWAVES + wave, NGW = F.G * NWAVES;
    for (int m0 = gw; m0 < ML; m0 += 2 * NGW) {
        const bool v1 = m0 + NGW < ML; const int mm[2] = {m0, v1 ? m0 + NGW : m0};
        f32x4 f[2][4]; f32x4 xo[2][4];
        P11Rows cur = st;
        if (m0 + 2 * NGW < ML) p11_load(a, m0 + 2 * NGW, NGW, lane, st);
        unsigned yv[2][16][4];
#pragma unroll
        for (int u = 0; u < 2; ++u) { const int m = mm[u], b = m >> 13;
            const u32x4 s0 = cur.s0[u], s1 = cur.s1[u];
            const unsigned sw[8] = {s0.x, s0.y, s0.z, s0.w, s1.x, s1.y, s1.z, s1.w};
#pragma unroll
            for (int e = 0; e < 16; ++e) {
                const int slot = __builtin_amdgcn_readfirstlane((int)(short)((sw[e >> 1] >> ((e & 1) * 16)) & 0xffffu));
                if (slot >= 0) {
                    const GAS unsigned* yr = (const GAS unsigned*)(ye + ((size_t)(b * 16 + e) * CAP + slot) * DM) + lane;
#pragma unroll
                    for (int j = 0; j < 4; ++j) yv[u][e][j] = yr[64 * j];
                }
            } }
#pragma unroll
        for (int u = 0; u < 2; ++u) {
            const u32x4 s0 = cur.s0[u], s1 = cur.s1[u];
            const unsigned sw[8] = {s0.x, s0.y, s0.z, s0.w, s1.x, s1.y, s1.z, s1.w};
#pragma unroll
            for (int j = 0; j < 4; ++j) { f[u][j] = f32x4{}; const u32x2 w = cur.xw[u][j]; xo[u][j] = (f32x4){__builtin_bit_cast(float, w.x << 16), __builtin_bit_cast(float, w.x & 0xffff0000u), __builtin_bit_cast(float, w.y << 16), __builtin_bit_cast(float, w.y & 0xffff0000u)}; }
#pragma unroll
            for (int e = 0; e < 16; ++e) {
                const int slot = __builtin_amdgcn_readfirstlane((int)(short)((sw[e >> 1] >> ((e & 1) * 16)) & 0xffffu));
                if (slot >= 0) {
#pragma unroll
                    for (int j = 0; j < 4; ++j) { const int w = (int)yv[u][e][j];
                        const f32x2 lo = __builtin_amdgcn_cvt_pk_f32_fp8(w, false), hi = __builtin_amdgcn_cvt_pk_f32_fp8(w, true);
                        f[u][j].x += lo.x; f[u][j].y += lo.y; f[u][j].z += hi.x; f[u][j].w += hi.y; }
                }
            } }
        float ss[2] = {0.f, 0.f};
#pragma unroll
        for (int u = 0; u < 2; ++u)
#pragma unroll
            for (int j = 0; j < 4; ++j) ss[u] += (f[u][j].x * f[u][j].x + f[u][j].y * f[u][j].y) + (f[u][j].z * f[u][j].z + f[u][j].w * f[u][j].w);
        ss[0] = wave_sum(ss[0]); ss[1] = wave_sum(ss[1]);
#pragma unroll
        for (int u = 0; u < 2; ++u) { if (u == 1 && !v1) break;
            const int m = mm[u], b = m >> 13; const float rstd = __builtin_amdgcn_rsqf(ss[u] * (1.f / (DM * Y8_SCALE * Y8_SCALE)) + NORM_EPS) * (1.f / Y8_SCALE);
            GAS f32x4* orow = (GAS f32x4*)(a.out + (size_t)m * DM) + lane;
#pragma unroll
            for (int j = 0; j < 4; ++j) { const int c = 4 * lane + 256 * j; const f32x4 p = *(const LAS f32x4*)(par + b * 1024 + c); __builtin_nontemporal_store(xo[u][j] + p * (f[u][j] * rstd), orow + 64 * j); } }
    }
}


namespace ctxp {
constexpr int AST = 144;
constexpr int L_A = 0, L_B = 64 * AST;
typedef int v8i_t __attribute__((ext_vector_type(8)));
__device__ __forceinline__ void tile(LAS unsigned char* lds, const unsigned char* hn8, const unsigned char* wt8, int t, bf16_t* P, bf16_t* KI, bf16_t* VI, const float* hglb) {
    const int tid = opaque_tid(), lane = tid & 63, hh = lane >> 5, r32 = lane & 31; const int wid = __builtin_amdgcn_readfirstlane(tid >> 6);
    const int rbk = t / 20, cb = t % 20, b = rbk >> 2;
    const int row0 = b * RB + (rbk & 3) * 64;
    const int col0 = 512 + cb * 128;
    const int lr = tid >> 3, lp = tid & 7;
    const GAS unsigned char* ag = (const GAS unsigned char*)(hn8 + (size_t)(row0 + lr) * DM + lp * 16);
    const GAS unsigned char* bg = (const GAS unsigned char*)(wt8 + (size_t)(col0 + lr) * DM + lp * 16);
    u32x4 ra[8], rb0[8], rb1[8];
#pragma unroll
    for (int kc = 0; kc < 8; ++kc) { ra[kc] = *(const GAS u32x4*)(ag + kc * 128); rb0[kc] = *(const GAS u32x4*)(bg + kc * 128); rb1[kc] = *(const GAS u32x4*)(bg + (size_t)64 * DM + kc * 128); }
    const int rb2 = wid & 1, cb4 = wid >> 1;
    f32x16 acc = {};
    constexpr int CH = 192 * AST;
#pragma unroll
    for (int rnd = 0; rnd < 2; ++rnd) {
        __syncthreads();
#pragma unroll
        for (int c4 = 0; c4 < 4; ++c4) { const int kc = rnd * 4 + c4; LAS unsigned char* lc = lds + c4 * CH;
            *(LAS u32x4*)(lc + L_A + lr * AST + lp * 16) = ra[kc]; *(LAS u32x4*)(lc + L_B + lr * AST + lp * 16) = rb0[kc]; *(LAS u32x4*)(lc + L_B + (lr + 64) * AST + lp * 16) = rb1[kc]; }
        __syncthreads();
#pragma unroll
        for (int c4 = 0; c4 < 4; ++c4)
#pragma unroll
            for (int kk = 0; kk < 2; ++kk) { const int ko = kk * 64 + hh * 32;
                LAS unsigned char* apf = lds + c4 * CH + L_A + (32 * rb2 + r32) * AST + ko; LAS unsigned char* bpf = lds + c4 * CH + L_B + (32 * cb4 + r32) * AST + ko;
                const u32x4 a0 = *(const LAS u32x4*)apf, a1 = *(const LAS u32x4*)(apf + 16), b0 = *(const LAS u32x4*)bpf, b1 = *(const LAS u32x4*)(bpf + 16);
                acc = __builtin_amdgcn_mfma_scale_f32_32x32x64_f8f6f4((v8i_t){(int)a0.x, (int)a0.y, (int)a0.z, (int)a0.w, (int)a1.x, (int)a1.y, (int)a1.z, (int)a1.w},
                                                                      (v8i_t){(int)b0.x, (int)b0.y, (int)b0.z, (int)b0.w, (int)b1.x, (int)b1.y, (int)b1.z, (int)b1.w}, acc, 0, 0, 0, 0, 0, 0); }
    }
#pragma unroll
    for (int r = 0; r < 16; ++r) acc[r] *= W8_INV;
    {
        const int cs_ = col0 + 32 * cb4 + r32;
        const int c = cs_ < 1024 ? ((cs_ & ~31) + ((cs_ >> 2) & 1) * 16 + ((cs_ >> 3) & 3) * 4 + (cs_ & 3)) : cs_;
        const int region = c >> 9;
        float lbv = 0.f;
        if (region == 3 || region == 4) { const int d = region - 3, cc = c & 511; lbv = 1.f - 1.f / (1.f + __expf(hglb[1024 + d * 512 + cc] - hglb[d * 512 + cc])); }
        if (region == 2) {
            const int cV = c - 1024, h = cV >> 7, dv = cV & 127;
            u32x4 w;
#pragma unroll
            for (int g = 0; g < 4; ++g) w[g] = cvt4_fp8_sat(acc[4 * g], acc[4 * g + 1], acc[4 * g + 2], acc[4 * g + 3]);
            *(u32x4*)((unsigned char*)VI + ((size_t)((b * 4 + h) * 132 + (rbk & 3))) * 8192 + dv * 64 + (((2 * hh + rb2) ^ ((dv >> 2) & 3)) * 16)) = w;
        } else {
#pragma unroll
        for (int r = 0; r < 16; ++r) {
            float v = acc[r];
            const int rr = (rbk & 3) * 64 + 32 * rb2 + att::crow(r, hh);
            if (region == 3 || region == 4) v = lbv * __builtin_amdgcn_rcpf(1.f + __expf(v));
            const bf16_t o = (bf16_t)cvt_pk_bf16(v, v);
            if (region == 1) { const int cK = c - 512, h = cK >> 7, comp = (cK >> 6) & 1, d = cK & 63, key = rr & 63;
                ((unsigned char*)KI)[((size_t)((b * 4 + h) * 132 + (rr >> 6))) * 8192 + comp * 4096 + key * 64 + (((d >> 4) ^ ((key >> 2) & 3)) * 16) + (d & 15)] = (unsigned char)(__builtin_amdgcn_cvt_pk_fp8_f32(sat8(v), 0.f, 0, false) & 0xff); }
            else P[(size_t)(b * RB + rr) * NPJ + (c - 1024)] = o;
        }
        }
    }
    __syncthreads();
}
}

__global__ void __launch_bounds__(NWAVES * 64, 2) fwd_kernel(Args args) {
    extern __shared__ __attribute__((aligned(16))) unsigned char lds[];
    Frame F;
    F.lds = (LAS unsigned char*)lds;
    F.MISC = (volatile LAS unsigned*)(F.lds + MISC_OFF);
    F.tid = threadIdx.x; F.lane = F.tid & 63; F.wave = __builtin_amdgcn_readfirstlane(F.tid >> 6);
    F.G = gridDim.x; { const int bx = blockIdx.x; F.vcu = (F.G % 8 == 0) ? (bx % 8) * (F.G / 8) + bx / 8 : bx; }
    unsigned char* ws = args.ws;
    F.ctl = (gu32*)(ws + WS_CTL);
    for (int u = F.tid; u < (LDS_BYTES - LDSCTL_OFF) / 4; u += NWAVES * 64) ((LAS unsigned*)(F.lds + LDSCTL_OFF))[u] = 0u;
    __syncthreads();
    XcdBarrier bar = xcd_barrier_post((unsigned*)(F.ctl + CW_BAR), F.MISC + 8);
    const int lo = args.ph_lo, hi = args.ph_hi;
    const bool galign = (F.G == 256);
    F.grp = F.vcu >> 5; F.rk = F.vcu & 31;
    if (galign) { F.p7_gw = 2048 * F.grp + F.rk * NWAVES + F.wave; F.p7_ngw = 256; F.p7_lim = 2048 * (F.grp + 1); }
    else { F.p7_gw = F.vcu * NWAVES + F.wave; F.p7_ngw = F.G * NWAVES; F.p7_lim = ML; }
    if (galign && threadIdx.x == 0) { unsigned* bw = (unsigned*)(F.ctl + CW_BAR);
        __hip_atomic_fetch_max(&bw[XB_GMAX(F.grp)], bar.x + 1u, __ATOMIC_RELAXED, __HIP_MEMORY_SCOPE_AGENT); __hip_atomic_fetch_max(&bw[XB_GMIN(F.grp)], 16u - bar.x, __ATOMIC_RELAXED, __HIP_MEMORY_SCOPE_AGENT); }
    bool use_local = false;
#define IN(k) (lo <= (k) && (k) < hi)
#define GRID_BAR() xcd_barrier(bar)
#define GROUP_BAR() do { if (use_local) xcd_barrier_local(bar); else xcd_barrier(bar); } while (0)

    P1Rows p1st;
    if (IN(0)) p0_prologue(F, args);
    if (IN(1)) p1_pre(F, args, p1st);
    if (IN(1)) { p1_norm(F, args, p1st); GRID_BAR(); }
    if (IN(0) && IN(1) && galign) {
        if (threadIdx.x == 0) { unsigned* bw = (unsigned*)(F.ctl + CW_BAR); unsigned ok = 1u;
            for (int g = 0; g < 8; ++g) ok &= (xb_ld(&bw[XB_GMAX(g)]) + xb_ld(&bw[XB_GMIN(g)]) == 17u) ? 1u : 0u;
            F.MISC[16] = ok; }
        __syncthreads();
        use_local = F.MISC[16] != 0u;
    }
    if (IN(2)) {
        for (int t = (int)blockIdx.x; t < 160; t += F.G) ctxp::tile(F.lds, ws + WS_HN8, ws + WS_WIN8, t, (bf16_t*)(ws + WS_PROJ), (bf16_t*)(ws + WS_KIMG), (bf16_t*)(ws + WS_VIMG), args.hglb);
        SchedInProj S; S.nM = ML / 256; S.nN = NIN / 256; S.nwg = S.nM * S.nN; S.G = F.G; S.c = (int)blockIdx.x; S.Bt = (const bf16_t*)(ws + WS_WIN8); S.K = DM / 2;
        EpiInProj E{(bf16_t*)(ws + WS_PROJ), (bf16_t*)(ws + WS_KIMG), (bf16_t*)(ws + WS_VIMG), (const f32x2*)(ws + WS_ROPE), args.hglb};
        pg8::gemm_phase<EpiInProj, SchedInProj, true, true>(F.lds, (const bf16_t*)(ws + WS_HN8), DM, S, E);
        GRID_BAR();
    }
    if (IN(4)) {
        if (galign) hg::h1_phase(F.lds, (const bf16_t*)(ws + WS_PROJ), (float*)(ws + WS_HGU), (float*)(ws + WS_HGD), 64 * F.grp + F.rk, 32, 64 * F.grp + F.rk + 64);
        else hg::h1_phase(F.lds, (const bf16_t*)(ws + WS_PROJ), (float*)(ws + WS_HGU), (float*)(ws + WS_HGD), F.vcu, F.G, 512);
        GROUP_BAR();
        if (galign) hg::scan_phase((float*)(ws + WS_HGU), (const float*)(ws + WS_HGD), 2 * F.grp + (F.rk >> 4), (F.rk & 15) * 512 + opaque_tid());
        else { const int gt_ = (int)(blockIdx.x * 512 + opaque_tid()); hg::scan_phase((float*)(ws + WS_HGU), (const float*)(ws + WS_HGD), gt_ >> 13, gt_ & 8191); }
        att2::attn_prefetch(F.lds, (const unsigned char*)(ws + WS_KIMG), (const unsigned char*)(ws + WS_VIMG), (int)(blockIdx.x & 7) >> 2, (int)blockIdx.x & 3);
        GROUP_BAR();
    }
    if (IN(3)) {
        float lam;
        { float d1 = 0.f, d2 = 0.f;
          for (int i = 0; i < 64; ++i) { d1 += args.lq1[i] * args.lk1[i]; d2 += args.lq2[i] * args.lk2[i]; }
          lam = __expf(d1) - __expf(d2) + LAMBDA_INIT; }
        const int bh = blockIdx.x & 7, sub = blockIdx.x >> 3;
        for (int i = 0; i < 2; ++i) att2::attn_unit(F.lds, (const bf16_t*)(ws + WS_PROJ), (const unsigned char*)(ws + WS_KIMG), (const unsigned char*)(ws + WS_VIMG), (bf16_t*)args.out, bh >> 2, bh & 3, sub + 32 * i, lam, args.da_subln);
    }
    if (IN(5)) {
        for (int u = F.vcu; u < 256; u += F.G) hg::h3_unit(F.lds, (const bf16_t*)(ws + WS_PROJ), (const float*)(ws + WS_HGU), (bf16_t*)args.out, args.out + 8388608, args.hg_norm, u);
        GRID_BAR();
    }
    if (IN(6)) {
        SchedPlain S; S.nM = ML / 256; S.nN = DM / 256; S.nwg = S.nM * S.nN; S.G = F.G; S.c = (int)blockIdx.x; S.Bt = (const bf16_t*)(ws + WS_WOUT); S.K = DM / 2;
        EpiYbf16 E{(bf16_t*)(ws + WS_YLAT), DM};
        pg8::gemm_phase<EpiYbf16, SchedPlain, false, true>(F.lds, (const bf16_t*)args.out, DM, S, E);
    }
    P7Rows p7st;
    if (IN(7)) p7_pre(F, args, p7st);
    if (IN(6)) GROUP_BAR();
    if (IN(7)) { p7_rowpass(F, args, p7st); GRID_BAR(); }
    if (IN(8)) {
        if (blockIdx.x < 32) topk_unit(F.lds, (const float*)(ws + WS_AFF), (int*)(ws + WS_SELIDX), (float*)(ws + WS_SELGATE), (short*)(ws + WS_SLOT), (int)blockIdx.x);
        else { const int t8 = opaque_tid(); const int w8 = __builtin_amdgcn_readfirstlane(t8 >> 6);
            if (galign) convert_items(F, args, 0, 1024, (((int)blockIdx.x >> 3) - 4) * NWAVES + w8, 28 * NWAVES, w8, t8 & 63, F.grp);
            else convert_items(F, args, P0_ITEMS_EARLY, P0_ITEMS_ALL, ((int)blockIdx.x - 32) * NWAVES + w8, (F.G - 32) * NWAVES, w8, t8 & 63); }
        GROUP_BAR();
    }
    if (IN(9)) {
        SchedMoe1 S{(int)blockIdx.x, (const bf16_t*)(ws + WS_WGU), (const int*)(ws + WS_SELIDX)};
        EpiSwiglu E{ws + WS_HB};
        pg8::gemm_phase<EpiSwiglu, SchedMoe1, true, true>(F.lds, (const bf16_t*)(ws + WS_H2), DM, S, E);
        GROUP_BAR();
    }
    if (IN(10)) {
        SchedMoe2 S{(int)blockIdx.x, (const bf16_t*)(ws + WS_WD)};
        EpiGateBf16 E{ws + WS_YE, (const float*)(ws + WS_SELGATE)};
        pg8::gemm_phase<EpiGateBf16, SchedMoe2, true, true>(F.lds, (const bf16_t*)(ws + WS_HB), FFD, S, E);
    }
    P11Rows p11st;
    if (IN(11)) p11_pre(F, args, p11st);
    if (IN(10)) GRID_BAR();
    if (IN(11)) p11_combine(F, args, p11st);
#undef IN
#undef GRID_BAR
}

extern "C" void kernel_launch(void* const* d_in, const int* in_sizes, int n_in, void* d_out, int out_size, void* d_ws, size_t ws_size, hipStream_t stream) {
    static int grid = 0;
    if (grid == 0) {
        if (n_in != 23 || in_sizes[0] != ML * DM || out_size != ML * DM || ws_size < WS_END) { fprintf(stderr, "kernel_launch: unexpected shapes (n_in %d, in0 %d, out %d, ws %zu)\n", n_in, n_in > 0 ? in_sizes[0] : -1, out_size, ws_size); grid = -1; return; }
        int dev = 0, cus = 0, per_cu = 0;
        if (hipGetDevice(&dev) != hipSuccess || hipDeviceGetAttribute(&cus, hipDeviceAttributeMultiprocessorCount, dev) != hipSuccess) { grid = -1; return; }
        if (hipFuncSetAttribute((const void*)fwd_kernel, hipFuncAttributeMaxDynamicSharedMemorySize, LDS_BYTES) != hipSuccess) { fprintf(stderr, "kernel_launch: hipFuncSetAttribute failed\n"); grid = -1; return; }
        if (hipOccupancyMaxActiveBlocksPerMultiprocessor(&per_cu, (const void*)fwd_kernel, NWAVES * 64, LDS_BYTES) != hipSuccess || per_cu < 1) { fprintf(stderr, "kernel_launch: occupancy query says %d blocks per CU\n", per_cu); (void)hipGetLastError(); grid = -1; return; }
        grid = cus;
    }
    if (grid < 0) return;
    if (hipMemsetAsync((char*)d_ws + WS_CTL, 0, CTL_ZERO_BYTES, stream) != hipSuccess) return;
    Args a{};
    const float** p = (const float**)&a;
    for (int i = 0; i < 23; ++i) p[i] = (const float*)d_in[i];
    a.out = (float*)d_out; a.ws = (unsigned char*)d_ws; a.ph_lo = 0; a.ph_hi = 12;
#if PROBE_PH >= 0
    a.ph_lo = 0; a.ph_hi = PROBE_PH + 1; hipLaunchKernelGGL(fwd_kernel, dim3(grid), dim3(NWAVES * 64), LDS_BYTES, stream, a);
    (void)hipMemsetAsync((char*)d_ws + WS_CTL, 0, CTL_ZERO_BYTES, stream);
    a.ph_lo = PROBE_PH; a.ph_hi = PROBE_PH + 1; hipLaunchKernelGGL(fwd_kernel, dim3(grid), dim3(NWAVES * 64), LDS_BYTES, stream, a);
    (void)hipMemsetAsync((char*)d_ws + WS_CTL, 0, CTL_ZERO_BYTES, stream);
    a.ph_lo = PROBE_PH + 1; a.ph_hi = 12; hipLaunchKernelGGL(fwd_kernel, dim3(grid), dim3(NWAVES * 64), LDS_BYTES, stream, a);
#else
    hipLaunchKernelGGL(fwd_kernel, dim3(grid), dim3(NWAVES * 64), LDS_BYTES, stream, a);
#endif
}
```
